# Optimizing an MI355X kernel written in HIP

```python
import math
import jax, jax.numpy as jnp
from jax import lax
import numpy as np

D_MODEL = 1024
BATCH = 8
SEQ = 2048
DEPTH = 4
DEC_BATCH = 128
DEC_SEQ = 4
PAST_LEN = 16384
PAGE_SIZE = 128

N_MIXERS = 2
N_MAMBA = (DEPTH + 1) // 2
N_RWKV = DEPTH // 2
N_VRES = max(N_RWKV - 1, 0)

D_FF = 2816
PLE_DIM = 256
NORM_EPS = 1e-6

M_D_INNER = 2 * D_MODEL
M_HEADDIM = 64
M_HEADS = M_D_INNER // M_HEADDIM
M_GROUPS = 8
M_HEADS_PER_GROUP = M_HEADS // M_GROUPS
M_STATE = 128
M_CONV_W = 4
M_CONV_DIM = M_D_INNER + 2 * M_GROUPS * M_STATE
M_IN_DIM = 2 * M_D_INNER + 2 * M_GROUPS * M_STATE + M_HEADS
M_CHUNK = 128
M_NORM_EPS = 1e-5

R_HEADDIM = 64
R_HEADS = D_MODEL // R_HEADDIM
R_DECAY_LORA = 64
R_AAA_LORA = 64
R_MV_LORA = 32
R_GATE_LORA = 160
R_GN_EPS = 64e-5

kernel_name = 'mamba2_rwkv7_macaron_ple_step'

RWKV_KEYS = ('r_mu', 'r_wr', 'r_wk', 'r_wv', 'r_wo', 'r_w0', 'r_w1', 'r_w2', 'r_a0', 'r_a1', 'r_a2',
             'r_g1', 'r_g2', 'r_k_k', 'r_k_a', 'r_r_k', 'r_gn_w', 'r_gn_b')


def rmsnorm(x, g, eps=NORM_EPS):
    xf = x.astype(jnp.float32)
    ms = jnp.mean(xf * xf, axis=-1, keepdims=True)
    return (xf * lax.rsqrt(ms + eps)).astype(x.dtype) * g


def swiglu(u, w_gate_up, w_down):
    gate, up = jnp.split(u @ w_gate_up, 2, axis=-1)
    return (jax.nn.silu(gate) * up) @ w_down


def causal_depthwise_conv(x, buf, w, b):
    L = x.shape[1]
    full = jnp.concatenate([buf.astype(x.dtype), x], axis=1)
    out = full[:, 0:L] * w[0]
    for k in range(1, M_CONV_W):
        out = out + full[:, k:k + L] * w[k]
    return out + b, full[:, L:]


def ssd_scan(x, dt, A, B, C, h0):
    bsz, L = x.shape[0], x.shape[1]
    Q = min(M_CHUNK, L)
    nc = -(-L // Q)
    pad = nc * Q - L
    if pad:
        padf = lambda t: jnp.pad(t, [(0, 0), (0, pad)] + [(0, 0)] * (t.ndim - 2))
        x, dt, B, C = padf(x), padf(dt), padf(B), padf(C)
    G, R = M_GROUPS, M_HEADS_PER_GROUP
    x = x.reshape(bsz, nc, Q, G, R, M_HEADDIM)
    dt = dt.reshape(bsz, nc, Q, G, R)
    B = B.reshape(bsz, nc, Q, G, M_STATE)
    C = C.reshape(bsz, nc, Q, G, M_STATE)
    a_cum = jnp.cumsum(dt * A.reshape(G, R), axis=2)
    seg = a_cum[:, :, :, None] - a_cum[:, :, None, :]
    causal = jnp.tril(jnp.ones((Q, Q), bool))[:, :, None, None]
    decay_ij = jnp.exp(jnp.where(causal, seg, -jnp.inf))
    xdt = x * dt[..., None]
    cb = jnp.einsum('bcign,bcjgn->bcijg', C, B)
    y_intra = jnp.einsum('bcijg,bcijgr,bcjgrp->bcigrp', cb, decay_ij, xdt)
    decay_end = jnp.exp(a_cum[:, :, -1:] - a_cum)
    chunk_states = jnp.einsum('bcjgn,bcjgr,bcjgrp->bcgrpn', B, decay_end, xdt)
    chunk_decay = jnp.exp(a_cum[:, :, -1])

    def step(h, inp):
        s, d = inp
        return h * d[..., None, None] + s, h

    h_last, h_starts = lax.scan(step, h0.reshape(bsz, G, R, M_HEADDIM, M_STATE),
                                (jnp.moveaxis(chunk_states, 1, 0), jnp.moveaxis(chunk_decay, 1, 0)))
    h_starts = jnp.moveaxis(h_starts, 0, 1)
    y_inter = jnp.einsum('bcign,bcigr,bcgrpn->bcigrp', C, jnp.exp(a_cum), h_starts)
    y = (y_intra + y_inter).reshape(bsz, nc * Q, M_HEADS, M_HEADDIM)[:, :L]
    return y, h_last.reshape(bsz, M_HEADS, M_HEADDIM, M_STATE)


def mamba2_mixer(u, h0, conv_buf, w_in, conv_w, conv_b, dt_bias, A_log, D_skip, norm_w, w_out):
    f32 = jnp.float32
    bsz, L, _ = u.shape
    z, xbc, dt = jnp.split(u @ w_in, [M_D_INNER, M_D_INNER + M_CONV_DIM], axis=-1)
    xbc, new_buf = causal_depthwise_conv(xbc, conv_buf, conv_w, conv_b)
    xbc = jax.nn.silu(xbc)
    xs, Bm, Cm = jnp.split(xbc, [M_D_INNER, M_D_INNER + M_GROUPS * M_STATE], axis=-1)
    dt = jax.nn.softplus((dt + dt_bias).astype(f32))
    A = -jnp.exp(A_log.astype(f32))
    xh = xs.reshape(bsz, L, M_HEADS, M_HEADDIM).astype(f32)
    y, h_new = ssd_scan(xh, dt, A,
                        Bm.reshape(bsz, L, M_GROUPS, M_STATE).astype(f32),
                        Cm.reshape(bsz, L, M_GROUPS, M_STATE).astype(f32),
                        h0.astype(f32))
    y = y + D_skip.astype(f32)[:, None] * xh
    y = y.reshape(bsz, L, M_D_INNER) * jax.nn.silu(z.astype(f32))
    yg = y.reshape(bsz, L, M_GROUPS, M_D_INNER // M_GROUPS)
    yg = yg * lax.rsqrt(jnp.mean(yg * yg, axis=-1, keepdims=True) + M_NORM_EPS)
    y = yg.reshape(bsz, L, M_D_INNER).astype(u.dtype) * norm_w
    return y @ w_out, h_new.astype(h0.dtype), new_buf.astype(conv_buf.dtype)


def rwkv7_mixer(u, S0, shift0, v_first, vres, mu, w_r, w_k, w_v, w_o, w0, w1, w2, a0, a1, a2,
                g1, g2, k_k, k_a, r_k, gn_w, gn_b):
    f32 = jnp.float32
    bsz, L, _ = u.shape
    u_prev = jnp.concatenate([shift0[:, None].astype(u.dtype), u[:, :-1]], axis=1)
    xx = u_prev - u
    mixed = u[None] + xx[None] * mu[:, None, None, :]
    xr, xw, xk, xv, xa, xg = mixed[0], mixed[1], mixed[2], mixed[3], mixed[4], mixed[5]
    r = xr @ w_r
    k = xk @ w_k
    v = xv @ w_v
    w = -jax.nn.softplus(-(w0 + jnp.tanh(xw @ w1) @ w2)) - 0.5
    a = jax.nn.sigmoid(a0 + (xa @ a1) @ a2)
    g = jax.nn.sigmoid(xg @ g1) @ g2
    if vres is None:
        v_first = v
    else:
        v0, v1, v2 = vres
        v = v + (v_first - v) * jax.nn.sigmoid(v0 + (xv @ v1) @ v2)
    heads = lambda t: t.reshape(bsz, L, R_HEADS, R_HEADDIM).astype(f32)
    kk = heads(k * k_k)
    kk = kk * lax.rsqrt(jnp.maximum(jnp.sum(kk * kk, axis=-1, keepdims=True), 1e-24))
    k = k * (1 + (a - 1) * k_a)
    rh, kh, vh, ah = heads(r), heads(k), heads(v), heads(a)
    decay = jnp.exp(-jnp.exp(heads(w)))

    def step(S, inp):
        r_t, d_t, k_t, v_t, kk_t, a_t = inp
        sa = jnp.einsum('bhij,bhj->bhi', S, -kk_t)
        S = (S * d_t[:, :, None, :] + sa[..., None] * (kk_t * a_t)[:, :, None, :]
             + v_t[..., None] * k_t[:, :, None, :])
        return S, jnp.einsum('bhij,bhj->bhi', S, r_t)

    tm = lambda t: jnp.moveaxis(t, 1, 0)
    S_new, y = lax.scan(step, S0.astype(f32), (tm(rh), tm(decay), tm(kh), tm(vh), tm(kk), tm(ah)))
    y = jnp.moveaxis(y, 0, 1)
    mean = jnp.mean(y, axis=-1, keepdims=True)
    var = jnp.mean(jnp.square(y - mean), axis=-1, keepdims=True)
    y = ((y - mean) * lax.rsqrt(var + R_GN_EPS)).reshape(bsz, L, D_MODEL) * gn_w + gn_b
    bonus = jnp.sum(rh * kh * r_k, axis=-1, keepdims=True) * vh
    y = y + bonus.reshape(bsz, L, D_MODEL)
    out = (y.astype(u.dtype) * g) @ w_o
    return out, S_new.astype(S0.dtype), u[:, -1].astype(shift0.dtype), v_first


def trunk(x, p, ssm0, conv0, wkv0, shift0, prm):
    h = x
    v_first = None
    ssm_new, conv_new, wkv_new, shift_new = [], [], [], []
    for i in range(DEPTH):
        j = i // N_MIXERS
        h = h + 0.5 * swiglu(rmsnorm(h, prm['norm_ffn1'][i]), prm['ffn1_gate_up'][i], prm['ffn1_down'][i])
        u = rmsnorm(h, prm['norm_mix'][i])
        if i % N_MIXERS == 0:
            mix, s_new, c_new = mamba2_mixer(u, ssm0[j], conv0[j], prm['m_in_proj'][j], prm['m_conv_w'][j],
                                             prm['m_conv_b'][j], prm['m_dt_bias'][j], prm['m_A_log'][j],
                                             prm['m_D'][j], prm['m_norm'][j], prm['m_out_proj'][j])
            ssm_new.append(s_new)
            conv_new.append(c_new)
        else:
            vres = None if j == 0 else (prm['r_v0'][j - 1], prm['r_v1'][j - 1], prm['r_v2'][j - 1])
            mix, s_new, sh_new, v_first = rwkv7_mixer(u, wkv0[j], shift0[j], v_first, vres,
                                                      *[prm[n][j] for n in RWKV_KEYS])
            wkv_new.append(s_new)
            shift_new.append(sh_new)
        h = h + mix
        h = h + 0.5 * swiglu(rmsnorm(h, prm['norm_ffn2'][i]), prm['ffn2_gate_up'][i], prm['ffn2_down'][i])
        gate = jax.nn.sigmoid(rmsnorm(h, prm['norm_ple'][i]) @ prm['ple_gate'][i])
        h = h + (p[i] @ prm['ple_in'][i]) * gate
    y = rmsnorm(h, prm['norm_final'])
    return y, jnp.stack(ssm_new), jnp.stack(conv_new), jnp.stack(wkv_new), jnp.stack(shift_new)


def setup_inputs(seed: int = 0) -> dict:
    key = jax.random.key(seed)
    ks = iter(jax.random.split(key, 64))
    f32 = jnp.float32

    def nrm(shape, scale=1.0):
        return jax.random.normal(next(ks), shape, f32) * scale

    def gain(shape):
        return 1.0 + nrm(shape, 0.02)

    def unif(shape, lo, hi):
        return jax.random.uniform(next(ks), shape, f32, lo, hi)

    NM, NR, NV = N_MAMBA, N_RWKV, N_VRES
    D = D_MODEL
    return {
        'x_prompt': nrm((BATCH, SEQ, D)),
        'x_sample': nrm((DEC_BATCH, DEC_SEQ, D)),
        'p_prompt': nrm((DEPTH, BATCH, SEQ, PLE_DIM)),
        'p_sample': nrm((DEPTH, DEC_BATCH, DEC_SEQ, PLE_DIM)),
        'state_ssm': nrm((NM, DEC_BATCH, M_HEADS, M_HEADDIM, M_STATE), 0.1),
        'state_conv': nrm((NM, DEC_BATCH, M_CONV_W - 1, M_CONV_DIM)),
        'state_wkv': nrm((NR, DEC_BATCH, R_HEADS, R_HEADDIM, R_HEADDIM), 0.1),
        'state_shift': nrm((NR, DEC_BATCH, D)),
        'norm_ffn1': gain((DEPTH, D)),
        'ffn1_gate_up': nrm((DEPTH, D, 2 * D_FF), D ** -0.5),
        'ffn1_down': nrm((DEPTH, D_FF, D), D_FF ** -0.5),
        'norm_mix': gain((DEPTH, D)),
        'norm_ffn2': gain((DEPTH, D)),
        'ffn2_gate_up': nrm((DEPTH, D, 2 * D_FF), D ** -0.5),
        'ffn2_down': nrm((DEPTH, D_FF, D), D_FF ** -0.5),
        'norm_ple': gain((DEPTH, D)),
        'ple_in': nrm((DEPTH, PLE_DIM, D), PLE_DIM ** -0.5),
        'ple_gate': nrm((DEPTH, D, D), D ** -0.5),
        'norm_final': gain((D,)),
        'm_in_proj': nrm((NM, D, M_IN_DIM), D ** -0.5),
        'm_conv_w': nrm((NM, M_CONV_W, M_CONV_DIM), M_CONV_W ** -0.5),
        'm_conv_b': nrm((NM, M_CONV_DIM), 0.02),
        'm_dt_bias': (lambda dt0: dt0 + jnp.log(-jnp.expm1(-dt0)))(
            jnp.exp(unif((NM, M_HEADS), math.log(1e-3), math.log(1e-1)))),
        'm_A_log': jnp.log(unif((NM, M_HEADS), 1.0, 16.0)),
        'm_D': gain((NM, M_HEADS)),
        'm_norm': gain((NM, M_D_INNER)),
        'm_out_proj': nrm((NM, M_D_INNER, D), M_D_INNER ** -0.5),
        'r_mu': unif((NR, 6, D), 0.0, 1.0),
        'r_wr': nrm((NR, D, D), D ** -0.5),
        'r_wk': nrm((NR, D, D), D ** -0.5),
        'r_wv': nrm((NR, D, D), D ** -0.5),
        'r_wo': nrm((NR, D, D), D ** -0.5),
        'r_w0': unif((NR, D), -6.0, -1.0),
        'r_w1': nrm((NR, D, R_DECAY_LORA), D ** -0.5),
        'r_w2': nrm((NR, R_DECAY_LORA, D), 0.1 * R_DECAY_LORA ** -0.5),
        'r_a0': nrm((NR, D), 0.1),
        'r_a1': nrm((NR, D, R_AAA_LORA), D ** -0.5),
        'r_a2': nrm((NR, R_AAA_LORA, D), 0.1 * R_AAA_LORA ** -0.5),
        'r_g1': nrm((NR, D, R_GATE_LORA), D ** -0.5),
        'r_g2': nrm((NR, R_GATE_LORA, D), R_GATE_LORA ** -0.5),
        'r_k_k': 0.85 + nrm((NR, D), 0.02),
        'r_k_a': gain((NR, D)),
        'r_r_k': nrm((NR, R_HEADS, R_HEADDIM), 0.1),
        'r_gn_w': gain((NR, D)),
        'r_gn_b': nrm((NR, D), 0.02),
        'r_v0': gain((NV, D)),
        'r_v1': nrm((NV, D, R_MV_LORA), D ** -0.5),
        'r_v2': nrm((NV, R_MV_LORA, D), 0.1 * R_MV_LORA ** -0.5),
    }


def reference(x_prompt, x_sample, p_prompt, p_sample, state_ssm, state_conv, state_wkv, state_shift,
              norm_ffn1, ffn1_gate_up, ffn1_down, norm_mix, norm_ffn2, ffn2_gate_up, ffn2_down,
              norm_ple, ple_in, ple_gate, norm_final,
              m_in_proj, m_conv_w, m_conv_b, m_dt_bias, m_A_log, m_D, m_norm, m_out_proj,
              r_mu, r_wr, r_wk, r_wv, r_wo, r_w0, r_w1, r_w2, r_a0, r_a1, r_a2, r_g1, r_g2,
              r_k_k, r_k_a, r_r_k, r_gn_w, r_gn_b, r_v0, r_v1, r_v2):
    prm = dict(norm_ffn1=norm_ffn1, ffn1_gate_up=ffn1_gate_up, ffn1_down=ffn1_down, norm_mix=norm_mix,
               norm_ffn2=norm_ffn2, ffn2_gate_up=ffn2_gate_up, ffn2_down=ffn2_down,
               norm_ple=norm_ple, ple_in=ple_in, ple_gate=ple_gate, norm_final=norm_final,
               m_in_proj=m_in_proj, m_conv_w=m_conv_w, m_conv_b=m_conv_b, m_dt_bias=m_dt_bias,
               m_A_log=m_A_log, m_D=m_D, m_norm=m_norm, m_out_proj=m_out_proj,
               r_mu=r_mu, r_wr=r_wr, r_wk=r_wk, r_wv=r_wv, r_wo=r_wo, r_w0=r_w0, r_w1=r_w1, r_w2=r_w2,
               r_a0=r_a0, r_a1=r_a1, r_a2=r_a2, r_g1=r_g1, r_g2=r_g2, r_k_k=r_k_k, r_k_a=r_k_a,
               r_r_k=r_r_k, r_gn_w=r_gn_w, r_gn_b=r_gn_b, r_v0=r_v0, r_v1=r_v1, r_v2=r_v2)
    bp = x_prompt.shape[0]
    dtp = x_prompt.dtype
    ssm0 = jnp.zeros((state_ssm.shape[0], bp) + state_ssm.shape[2:], dtp)
    conv0 = jnp.zeros((state_conv.shape[0], bp) + state_conv.shape[2:], dtp)
    wkv0 = jnp.zeros((state_wkv.shape[0], bp) + state_wkv.shape[2:], dtp)
    shift0 = jnp.zeros((state_shift.shape[0], bp) + state_shift.shape[2:], dtp)
    y_prompt, ssm_p, conv_p, wkv_p, shift_p = trunk(x_prompt, p_prompt, ssm0, conv0, wkv0, shift0, prm)
    y_sample, ssm_s, conv_s, wkv_s, shift_s = trunk(x_sample, p_sample, state_ssm, state_conv,
                                                    state_wkv, state_shift, prm)
    return (y_prompt, y_sample, ssm_p, conv_p, wkv_p, shift_p, ssm_s, conv_s, wkv_s, shift_s)
```

```cpp
#include <hip/hip_runtime.h>
#include <hip/hip_cooperative_groups.h>
#include <cstdio>
#include <cstdint>
namespace cg = cooperative_groups;
#define MK_PER_PHASE 0
#define MK_DUP 0
namespace pg8 {
#define PG8_LAS __attribute__((address_space(3)))
typedef unsigned short bf16_t;
typedef short bf16x8 __attribute__((ext_vector_type(8)));
typedef float f32x4 __attribute__((ext_vector_type(4)));
typedef unsigned u32x4 __attribute__((ext_vector_type(4)));
constexpr int BM = 256, BK = 64, HALF = 128, HTB = HALF * BK * 2  , STAGE_BYTES = 8 * HTB, NXCD = 8, WGM = 8;

__host__ __device__ __forceinline__ int lds_byte(int r, int c) { const int st = (r >> 4) * 2 + (c >> 5), rr = r & 15, cc = c & 31, ob = rr * 64 + cc * 2; return st * 1024 + (ob ^ (((ob >> 9) & 1) << 5)); }
__host__ __device__ __forceinline__ void stage_rc(int b, int& R, int& C) { const int st = b / 1024, sb = b % 1024, swz = sb ^ (((sb >> 9) & 1) << 5); R = (st >> 1) * 16 + swz / 64; C = (st & 1) * 32 + (swz % 64) / 2; }
__host__ __device__ __forceinline__ int perm32(int rho) { const int n = rho >> 4, i = rho & 15; return 8 * (i >> 2) + 4 * n + (i & 3); }

struct Unit { int pm, pn; };
struct Gemm { const bf16_t* A; const bf16_t* Bt; int M, N, K; };

struct StaticOrder {
    int nM, nN, nwg, G, c;
    __host__ __device__ void init(int M, int N, int G_, int c_) { nM = M / BM; nN = N / BM; nwg = nM * nN; G = G_; c = c_; }
    __host__ __device__ bool next(int i, Unit& u) const {
        const long L = (long)i * G + c; if (L >= nwg) return false;
        int wgid = (int)L; { const int q = nwg / NXCD, r = nwg % NXCD, xcd = wgid % NXCD, off = wgid / NXCD; wgid = (xcd < r ? xcd * (q + 1) : r * (q + 1) + (xcd - r) * q) + off; }
        const int nig = WGM * nN, gid = wgid / nig, fm = gid * WGM, gsz = (nM - fm) < WGM ? (nM - fm) : WGM;
        u.pm = fm + ((wgid % nig) % gsz); u.pn = (wgid % nig) / gsz; return true;
    }
    __device__ __forceinline__ void a_ready(const Unit&) const {}
    __device__ __forceinline__ void done(const Unit&) const {}
};

typedef float f32x2 __attribute__((ext_vector_type(2)));
typedef __bf16 bf16x2_cv __attribute__((ext_vector_type(2)));
__device__ __forceinline__ unsigned cvt_pk_bf16(float lo, float hi) { const f32x2 v = {lo, hi}; const bf16x2_cv b = __builtin_convertvector(v, bf16x2_cv); return __builtin_bit_cast(unsigned, b); }
typedef unsigned u32x2 __attribute__((ext_vector_type(2)));
__device__ __forceinline__ float sigm(float x) { return __builtin_amdgcn_rcpf(1.f + __expf(-x)); }
__device__ __forceinline__ float sigm_fast(float x) { return __builtin_amdgcn_rcpf(1.f + __expf(-x)); }
__device__ __forceinline__ float silu_f(float x) { return x * __builtin_amdgcn_rcpf(1.f + __expf(-x)); }
__device__ __forceinline__ float rowscale(const float* ss, int row) {
    const f32x4 a = *(const f32x4*)(ss + (size_t)row * 16), b = *(const f32x4*)(ss + (size_t)row * 16 + 4), c = *(const f32x4*)(ss + (size_t)row * 16 + 8), d = *(const f32x4*)(ss + (size_t)row * 16 + 12);
    const float t = ((a[0] + a[1]) + (a[2] + a[3])) + ((b[0] + b[1]) + (b[2] + b[3])) + ((c[0] + c[1]) + (c[2] + c[3])) + ((d[0] + d[1]) + (d[2] + d[3]));
    return rsqrtf(t * (1.f / 1024.f) + 1e-6f); }

__device__ __forceinline__ void rowscales8(const float* ss, int row0, int fq, float (&sc)[8]) {
    f32x4 v[8];
#pragma unroll
    for (int r = 0; r < 8; ++r) v[r] = *(const f32x4*)(ss + (size_t)(row0 + (r >> 2) * HALF + (r & 3) * 16) * 16 + 4 * fq);
#pragma unroll
    for (int r = 0; r < 8; ++r) { float t = (v[r][0] + v[r][1]) + (v[r][2] + v[r][3]); t += __shfl_xor(t, 16); t += __shfl_xor(t, 32); sc[r] = rsqrtf(t * (1.f / 1024.f) + 1e-6f); }
    asm volatile("" ::: "memory");
}
struct EpiSwiGLU {
    static constexpr bool PERM = true, AFTER_DRAIN = false;
    const float* ss; bf16_t* act;
    __device__ __forceinline__ void operator()(const f32x4 (&acc)[2][2][4][2], const Unit& u, int wr, int wc, int fr, int fq) const {
        const int row0 = u.pm * BM + wr * 64 + fr, ff0 = u.pn * 128 + wc * 32 + 8 * fq;
        float sc[8]; rowscales8(ss, row0, fq, sc);
#pragma unroll
        for (int ai = 0; ai < 2; ++ai)
#pragma unroll
            for (int m = 0; m < 4; ++m) {
                const int row = row0 + ai * HALF + m * 16;
                const float s = sc[ai * 4 + m];
                float o[8];
#pragma unroll
                for (int n = 0; n < 2; ++n)
#pragma unroll
                    for (int e = 0; e < 4; ++e) { const float g = acc[ai][0][m][n][e] * s, up = acc[ai][1][m][n][e] * s; o[4 * n + e] = silu_f(g) * up; }
                u32x4 w; w.x = cvt_pk_bf16(o[0], o[1]); w.y = cvt_pk_bf16(o[2], o[3]); w.z = cvt_pk_bf16(o[4], o[5]); w.w = cvt_pk_bf16(o[6], o[7]);
                *(u32x4*)(act + (size_t)row * 2816 + ff0) = w; asm volatile("" ::: "memory");
            }
    }
};
template <int MODE> struct EpiResid {
    static constexpr bool PERM = false, AFTER_DRAIN = false;
    const bf16_t* hin; bf16_t* hout; float* ssn; float alpha; const bf16_t* pe; const float* ssc;
    __device__ __forceinline__ void operator()(const f32x4 (&acc)[2][2][4][2], const Unit& u, int wr, int wc, int fr, int fq) const {
        const int row0 = u.pm * BM + wr * 64 + fr, col0 = u.pn * BM + wc * 32 + 4 * fq;
        float sc[8]; if (MODE == 1) rowscales8(ssc, row0, fq, sc);
#pragma unroll
        for (int ai = 0; ai < 2; ++ai)
#pragma unroll
            for (int m = 0; m < 4; ++m) {
                const int row = row0 + ai * HALF + m * 16;
                float s = 0.f; if (MODE == 1) s = sc[ai * 4 + m];
                float q = 0.f;
#pragma unroll
                for (int bj = 0; bj < 2; ++bj)
#pragma unroll
                    for (int n = 0; n < 2; ++n) {
                        const size_t off = (size_t)row * 1024 + col0 + bj * HALF + n * 16;
                        const u32x2 hw = *(const u32x2*)(hin + off); const f32x4 a = acc[ai][bj][m][n];
                        f32x4 hv; hv[0] = __builtin_bit_cast(float, hw.x << 16); hv[1] = __builtin_bit_cast(float, hw.x & 0xffff0000u); hv[2] = __builtin_bit_cast(float, hw.y << 16); hv[3] = __builtin_bit_cast(float, hw.y & 0xffff0000u);
                        if (MODE == 0) { hv = hv + a * alpha; }
                        else { const u32x2 pw = *(const u32x2*)(pe + off); f32x4 pv; pv[0] = __builtin_bit_cast(float, pw.x << 16); pv[1] = __builtin_bit_cast(float, pw.x & 0xffff0000u); pv[2] = __builtin_bit_cast(float, pw.y << 16); pv[3] = __builtin_bit_cast(float, pw.y & 0xffff0000u);
#pragma unroll
                            for (int e = 0; e < 4; ++e) hv[e] += pv[e] * sigm(s * a[e]); }
                        u32x2 w; w.x = cvt_pk_bf16(hv[0], hv[1]); w.y = cvt_pk_bf16(hv[2], hv[3]);
                        *(u32x2*)(hout + off) = w;
                        const float r0 = __builtin_bit_cast(float, w.x << 16), r1 = __builtin_bit_cast(float, w.x & 0xffff0000u), r2 = __builtin_bit_cast(float, w.y << 16), r3 = __builtin_bit_cast(float, w.y & 0xffff0000u);
                        q += (r0 * r0 + r1 * r1) + (r2 * r2 + r3 * r3);
                    }
                q += __shfl_xor(q, 16); q += __shfl_xor(q, 32);
                if (fq == 0) ssn[(size_t)row * 16 + u.pn * 4 + wc] = q; asm volatile("" ::: "memory");
            }
    }
};
struct EpiInProj {
    static constexpr bool PERM = true, AFTER_DRAIN = false;
    const float* ss; bf16_t* zx; float* dtraw;
    __device__ __forceinline__ void operator()(const f32x4 (&acc)[2][2][4][2], const Unit& u, int wr, int wc, int fr, int fq) const {
        const int row0 = u.pm * BM + wr * 64 + fr, col0 = u.pn * BM + wc * 32 + 8 * fq;
        float sc[8]; rowscales8(ss, row0, fq, sc);
#pragma unroll
        for (int ai = 0; ai < 2; ++ai)
#pragma unroll
            for (int m = 0; m < 4; ++m) {
                const int row = row0 + ai * HALF + m * 16;
                const float s = sc[ai * 4 + m];
                if (u.pn < 24) {
#pragma unroll
                    for (int bj = 0; bj < 2; ++bj) { const f32x4 v0 = acc[ai][bj][m][0] * s, v1 = acc[ai][bj][m][1] * s;
                        u32x4 w; w.x = cvt_pk_bf16(v0[0], v0[1]); w.y = cvt_pk_bf16(v0[2], v0[3]); w.z = cvt_pk_bf16(v1[0], v1[1]); w.w = cvt_pk_bf16(v1[2], v1[3]);
                        *(u32x4*)(zx + (size_t)row * 6144 + col0 + bj * HALF) = w; }
                } else if (wc == 0) {
                    *(f32x4*)(dtraw + (size_t)row * 32 + 8 * fq) = acc[ai][0][m][0] * s;
                    *(f32x4*)(dtraw + (size_t)row * 32 + 8 * fq + 4) = acc[ai][0][m][1] * s;
                }
                asm volatile("" ::: "memory");
            }
    }
};
struct EpiRkv {
    static constexpr bool PERM = false, AFTER_DRAIN = false;
    bf16_t* rk; bf16_t* v; bf16_t* hid;
    __device__ __forceinline__ void operator()(const f32x4 (&acc)[2][2][4][2], const Unit& u, int wr, int wc, int fr, int fq) const {
        const int row0 = u.pm * BM + wr * 64 + fr;
        if (u.pn < 12) {
            bf16_t* dst = u.pn < 8 ? rk + (size_t)(u.pn >> 2) * ((size_t)16896 * 1024) : v;
            const int col0 = (u.pn & 3) * BM + wc * 32 + 4 * fq;
#pragma unroll
            for (int ai = 0; ai < 2; ++ai)
#pragma unroll
                for (int m = 0; m < 4; ++m) { const int row = row0 + ai * HALF + m * 16;
#pragma unroll
                    for (int bj = 0; bj < 2; ++bj)
#pragma unroll
                        for (int n = 0; n < 2; ++n) { const f32x4 a = acc[ai][bj][m][n]; u32x2 w; w.x = cvt_pk_bf16(a[0], a[1]); w.y = cvt_pk_bf16(a[2], a[3]); *(u32x2*)(dst + (size_t)row * 1024 + col0 + bj * HALF + n * 16) = w; } asm volatile("" ::: "memory"); }
        } else {
            const int col0 = (u.pn - 12) * BM + wc * 32 + 4 * fq;
#pragma unroll
            for (int ai = 0; ai < 2; ++ai)
#pragma unroll
                for (int m = 0; m < 4; ++m) { const int row = row0 + ai * HALF + m * 16;
#pragma unroll
                    for (int bj = 0; bj < 2; ++bj)
#pragma unroll
                        for (int n = 0; n < 2; ++n) { const int lc = col0 + bj * HALF + n * 16;
                            if (lc < 384) { f32x4 a = acc[ai][bj][m][n];
                                if (lc < 64) { a[0] = tanhf(a[0]); a[1] = tanhf(a[1]); a[2] = tanhf(a[2]); a[3] = tanhf(a[3]); }
                                else if (lc >= 128 && lc < 288) { a[0] = sigm(a[0]); a[1] = sigm(a[1]); a[2] = sigm(a[2]); a[3] = sigm(a[3]); }
                                else if (lc >= 320) { a = (f32x4){0.f, 0.f, 0.f, 0.f}; }
                                u32x2 w; w.x = cvt_pk_bf16(a[0], a[1]); w.y = cvt_pk_bf16(a[2], a[3]);
                                *(u32x2*)(hid + (size_t)row * 384 + lc) = w; } } asm volatile("" ::: "memory"); }
        }
    }
};
struct EpiLora2 {
    static constexpr bool PERM = false, AFTER_DRAIN = false;
    float* dd; bf16_t* agv; const float* w0; const float* a0; const float* v0;
    template <int Q> __device__ __forceinline__ void body(const f32x4 (&acc)[2][2][4][2], const float* bias, int row0, int col0) const {
#pragma unroll
        for (int bj = 0; bj < 2; ++bj)
#pragma unroll
            for (int n = 0; n < 2; ++n) { const int col = col0 + bj * HALF + n * 16;
                f32x4 bv = (f32x4){0.f, 0.f, 0.f, 0.f}; if (Q != 2) bv = *(const f32x4*)(bias + col);
#pragma unroll
                for (int ai = 0; ai < 2; ++ai)
#pragma unroll
                    for (int m = 0; m < 4; ++m) { const int row = row0 + ai * HALF + m * 16; f32x4 x = acc[ai][bj][m][n] + bv;
                        if (Q == 0) {
#pragma unroll
                            for (int e = 0; e < 4; ++e) { const float y = -x[e]; const float sp = fmaxf(y, 0.f) + log1pf(__expf(-fabsf(y))); x[e] = __expf(-__expf(-sp - 0.5f)); } }
                        else if (Q != 2) { x[0] = sigm_fast(x[0]); x[1] = sigm_fast(x[1]); x[2] = sigm_fast(x[2]); x[3] = sigm_fast(x[3]); }
                        if (Q == 0) *(f32x4*)(dd + (size_t)row * 1024 + col) = x;
                        else { u32x2 w; w.x = cvt_pk_bf16(x[0], x[1]); w.y = cvt_pk_bf16(x[2], x[3]); *(u32x2*)(agv + (size_t)(Q - 1) * ((size_t)16896 * 1024) + (size_t)row * 1024 + col) = w; }
                        asm volatile("" ::: "memory"); } }
    }
    __device__ __forceinline__ void operator()(const f32x4 (&acc)[2][2][4][2], const Unit& u, int wr, int wc, int fr, int fq) const {
        const int row0 = u.pm * BM + wr * 64 + fr, q = u.pn >> 2, col0 = (u.pn & 3) * BM + wc * 32 + 4 * fq;
        if (q == 0) body<0>(acc, w0, row0, col0);
        else if (q == 1) body<1>(acc, a0, row0, col0);
        else if (q == 2) body<2>(acc, nullptr, row0, col0);
        else body<3>(acc, v0, row0, col0);
    }
};
struct EpiPlain {
    static constexpr bool PERM = false, AFTER_DRAIN = false;
    bf16_t* o; int ldc;
    __device__ __forceinline__ void operator()(const f32x4 (&acc)[2][2][4][2], const Unit& u, int wr, int wc, int fr, int fq) const {
        const int row0 = u.pm * BM + wr * 64 + fr, col0 = u.pn * BM + wc * 32 + 4 * fq;
#pragma unroll
        for (int ai = 0; ai < 2; ++ai)
#pragma unroll
            for (int m = 0; m < 4; ++m) { const int row = row0 + ai * HALF + m * 16;
#pragma unroll
                for (int bj = 0; bj < 2; ++bj)
#pragma unroll
                    for (int n = 0; n < 2; ++n) { const f32x4 a = acc[ai][bj][m][n]; u32x2 w; w.x = cvt_pk_bf16(a[0], a[1]); w.y = cvt_pk_bf16(a[2], a[3]); *(u32x2*)(o + (size_t)row * ldc + col0 + bj * HALF + n * 16) = w; }
                asm volatile("" ::: "memory"); }
    }
};
template <class Epi, class Sched, bool ALIGN_EPI = false, bool SP2 = false>
__device__ __forceinline__ void gemm_phase(PG8_LAS unsigned char* lds, const Gemm g, const Sched& S, const Epi& E) {
    int tid_ = threadIdx.x; asm volatile("" : "+v"(tid_)); const int tid = tid_, wid = __builtin_amdgcn_readfirstlane(tid >> 6), lane = tid & 63, wr = wid >> 2, wc = wid & 3, fr = lane & 15, fq = lane >> 4;
    const int K = g.K, nt = K / BK;
    unsigned voffA[2], voffB[2];
#pragma unroll
    for (int i = 0; i < 2; ++i) { int R, C; stage_rc(tid * 16 + i * 8192, R, C); const int Rb = Epi::PERM ? ((R & ~31) + perm32(R & 31)) : R;
        voffA[i] = (unsigned)(R * K + C) * 2u; voffB[i] = (unsigned)(Rb * K + C) * 2u; }
    const size_t kstep = (size_t)(BK * 2);
    const size_t hstep = (size_t)HALF * K * 2;
    const size_t tstep = 2 * hstep;
    const unsigned ldsw = (unsigned)wid * 1024u;
    const int aoff = lds_byte(wr * 64 + fr, fq * 8), boff = lds_byte(wc * 32 + fr, fq * 8);
#define PG8_SA(b, h) (((b) * 2 + (h)) * HTB)
#define PG8_SB(b, h) ((4 + (b) * 2 + (h)) * HTB)
#define PG8_STAGE(bufoff, gbase, voff) do { _Pragma("unroll") for (int _i = 0; _i < 2; ++_i) \
        __builtin_amdgcn_global_load_lds((const unsigned*)((const char*)(gbase) + (voff)[_i]), (PG8_LAS unsigned*)(lds + (bufoff) + ldsw + _i * 8192), 16, 0, 0); } while (0)
#define PG8_LDA(dst, b, h) do { _Pragma("unroll") for (int m = 0; m < 4; ++m) _Pragma("unroll") for (int k = 0; k < 2; ++k) dst[m][k] = *(const PG8_LAS bf16x8*)(lds + PG8_SA(b, h) + aoff + m * 2048 + k * 1024); } while (0)
#define PG8_LDB(dst, b, h) do { _Pragma("unroll") for (int n = 0; n < 2; ++n) _Pragma("unroll") for (int k = 0; k < 2; ++k) dst[n][k] = *(const PG8_LAS bf16x8*)(lds + PG8_SB(b, h) + boff + n * 2048 + k * 1024); } while (0)
#define PG8_MMA(ai, bj, At, Bt) do { __builtin_amdgcn_s_setprio(1); _Pragma("unroll") for (int m = 0; m < 4; ++m) _Pragma("unroll") for (int n = 0; n < 2; ++n) _Pragma("unroll") for (int k = 0; k < 2; ++k) \
        acc[ai][bj][m][n] = __builtin_amdgcn_mfma_f32_16x16x32_bf16(Bt[n][k], At[m][k], acc[ai][bj][m][n], 0, 0, 0); __builtin_amdgcn_s_setprio(0); } while (0)
#define PG8_WAIT_V(n) asm volatile("s_waitcnt vmcnt(" #n ")" ::: "memory")
#define PG8_WAIT_L(n) asm volatile("s_waitcnt lgkmcnt(" #n ")" ::: "memory")
#define PG8_BAR __builtin_amdgcn_s_barrier()
#define PG8_SCHED __builtin_amdgcn_sched_barrier(0)
    Unit cur, nxt; int ui = 0;
    if (!S.next(0, cur)) return;
    f32x4 acc[2][2][4][2];
#pragma unroll
    for (int a = 0; a < 2; ++a)
#pragma unroll
        for (int b = 0; b < 2; ++b)
#pragma unroll
            for (int m = 0; m < 4; ++m)
#pragma unroll
                for (int n = 0; n < 2; ++n) acc[a][b][m][n] = (f32x4){0.f, 0.f, 0.f, 0.f};
    bf16x8 At[4][2], B0[2][2], B1[2][2];
    const char* cA = (const char*)g.A + (size_t)cur.pm * tstep; const char* cB = (const char*)g.Bt + (size_t)cur.pn * tstep;
    S.a_ready(cur);
    if constexpr (SP2) {
        PG8_STAGE(PG8_SB(0, 0), cB, voffB); PG8_STAGE(PG8_SB(0, 1), cB + hstep, voffB); PG8_STAGE(PG8_SA(0, 0), cA, voffA); PG8_STAGE(PG8_SA(0, 1), cA + hstep, voffA);
        if (wr == 1) PG8_BAR;
        PG8_WAIT_V(2); PG8_BAR;
        PG8_STAGE(PG8_SB(1, 0), cB + kstep, voffB); PG8_STAGE(PG8_SA(1, 0), cA + kstep, voffA); PG8_STAGE(PG8_SB(1, 1), cB + hstep + kstep, voffB);
        PG8_WAIT_V(6); PG8_BAR;
    } else {
        PG8_STAGE(PG8_SB(0, 0), cB, voffB); PG8_STAGE(PG8_SA(0, 0), cA, voffA); PG8_STAGE(PG8_SB(0, 1), cB + hstep, voffB); PG8_STAGE(PG8_SA(0, 1), cA + hstep, voffA);
        if (wr == 1) PG8_BAR;
        PG8_WAIT_V(4); PG8_BAR;
        PG8_STAGE(PG8_SB(1, 0), cB + kstep, voffB); PG8_STAGE(PG8_SA(1, 0), cA + kstep, voffA); PG8_STAGE(PG8_SB(1, 1), cB + hstep + kstep, voffB);
        PG8_WAIT_V(6); PG8_BAR;
    }
    for (;;) {
        const bool has_next = S.next(ui + 1, nxt);
        const char* nA = has_next ? (const char*)g.A + (size_t)nxt.pm * tstep : cA; const char* nB = has_next ? (const char*)g.Bt + (size_t)nxt.pn * tstep : cB;
#pragma unroll 1
        for (int t = 0; t < nt; t += 2) {
            const bool last = (t == nt - 2);
            const char* a1 = cA + (size_t)(t + 1) * kstep;
            const char* a2 = last ? nA : cA + (size_t)(t + 2) * kstep; const char* b2 = last ? nB : cB + (size_t)(t + 2) * kstep;
            const char* a3 = a2 + kstep; const char* b3 = b2 + kstep;
            if (last && has_next) S.a_ready(nxt);
            if constexpr (SP2) {
            PG8_LDB(B0, 0, 0); PG8_LDB(B1, 0, 1); PG8_SCHED; PG8_LDA(At, 0, 0); PG8_STAGE(PG8_SA(1, 1), a1 + hstep, voffA);
            PG8_WAIT_V(8); PG8_WAIT_L(0); PG8_BAR; PG8_MMA(0, 0, At, B0); PG8_MMA(0, 1, At, B1); PG8_BAR; PG8_SCHED;
            PG8_LDA(At, 0, 1); PG8_STAGE(PG8_SB(0, 0), b2, voffB); PG8_STAGE(PG8_SB(0, 1), b2 + hstep, voffB); PG8_STAGE(PG8_SA(0, 0), a2, voffA);
            PG8_WAIT_V(8); PG8_WAIT_L(0); PG8_BAR; PG8_MMA(1, 0, At, B0); PG8_MMA(1, 1, At, B1); PG8_BAR; PG8_SCHED;
            PG8_LDB(B0, 1, 0); PG8_LDB(B1, 1, 1); PG8_SCHED; PG8_LDA(At, 1, 0); PG8_STAGE(PG8_SA(0, 1), a2 + hstep, voffA);
            PG8_WAIT_V(8); PG8_WAIT_L(0); PG8_BAR; PG8_MMA(0, 0, At, B0); PG8_MMA(0, 1, At, B1); PG8_BAR; PG8_SCHED;
            PG8_LDA(At, 1, 1); PG8_STAGE(PG8_SB(1, 0), b3, voffB); PG8_STAGE(PG8_SB(1, 1), b3 + hstep, voffB); PG8_STAGE(PG8_SA(1, 0), a3, voffA);
            PG8_WAIT_V(8); PG8_WAIT_L(0); PG8_BAR; PG8_MMA(1, 0, At, B0); PG8_MMA(1, 1, At, B1); PG8_BAR; PG8_SCHED;
            } else {
            PG8_LDB(B0, 0, 0); PG8_SCHED; PG8_LDA(At, 0, 0); PG8_STAGE(PG8_SA(1, 1), a1 + hstep, voffA);
            PG8_WAIT_L(8); PG8_BAR; PG8_WAIT_L(0); PG8_MMA(0, 0, At, B0); PG8_BAR; PG8_SCHED;
            PG8_LDB(B1, 0, 1); PG8_STAGE(PG8_SB(0, 0), b2, voffB);
            PG8_BAR; PG8_WAIT_L(0); PG8_MMA(0, 1, At, B1); PG8_BAR;
            PG8_LDA(At, 0, 1); PG8_STAGE(PG8_SA(0, 0), a2, voffA);
            PG8_BAR; PG8_WAIT_L(0); PG8_MMA(1, 0, At, B0); PG8_BAR; PG8_SCHED;
            PG8_STAGE(PG8_SB(0, 1), b2 + hstep, voffB);
            PG8_WAIT_V(6); PG8_BAR; PG8_MMA(1, 1, At, B1); PG8_BAR;
            PG8_LDB(B0, 1, 0); PG8_SCHED; PG8_LDA(At, 1, 0); PG8_STAGE(PG8_SA(0, 1), a2 + hstep, voffA);
            PG8_WAIT_L(8); PG8_BAR; PG8_WAIT_L(0); PG8_MMA(0, 0, At, B0); PG8_BAR; PG8_SCHED;
            PG8_LDB(B1, 1, 1); PG8_STAGE(PG8_SB(1, 0), b3, voffB);
            PG8_BAR; PG8_WAIT_L(0); PG8_MMA(0, 1, At, B1); PG8_BAR;
            PG8_LDA(At, 1, 1); PG8_STAGE(PG8_SA(1, 0), a3, voffA);
            PG8_BAR; PG8_WAIT_L(0); PG8_MMA(1, 0, At, B0); PG8_BAR; PG8_SCHED;
            PG8_STAGE(PG8_SB(1, 1), b3 + hstep, voffB);
            PG8_WAIT_V(6); PG8_BAR; PG8_MMA(1, 1, At, B1); PG8_BAR;
            }
        }
        if constexpr (ALIGN_EPI) { if (wr == 0) PG8_BAR; }
        if constexpr (!Epi::AFTER_DRAIN) { E(acc, cur, wr, wc, fr, fq); S.done(cur); }
        if (!has_next) break;
#pragma unroll
        for (int a = 0; a < 2; ++a)
#pragma unroll
            for (int b = 0; b < 2; ++b)
#pragma unroll
                for (int m = 0; m < 4; ++m)
#pragma unroll
                    for (int n = 0; n < 2; ++n) acc[a][b][m][n] = (f32x4){0.f, 0.f, 0.f, 0.f};
        cur = nxt; cA = nA; cB = nB; ++ui;
        if constexpr (ALIGN_EPI) { if (wr == 1) PG8_BAR; }
    }
    PG8_WAIT_V(0);
    if constexpr (!ALIGN_EPI) { if (wr == 0) PG8_BAR; }
    PG8_BAR;
    if constexpr (Epi::AFTER_DRAIN) { E.fused(acc, cur, wr, wc, fr, fq, lds, wid, lane); S.done(cur); }
#undef PG8_SA
#undef PG8_SB
#undef PG8_STAGE
#undef PG8_LDA
#undef PG8_LDB
#undef PG8_MMA
#undef PG8_WAIT_V
#undef PG8_WAIT_L
#undef PG8_BAR
#undef PG8_SCHED
}
}
#define LAS __attribute__((address_space(3)))
typedef pg8::bf16_t bf16_t;
typedef pg8::f32x4 f32x4;
typedef pg8::u32x4 u32x4;
typedef pg8::u32x2 u32x2;
using pg8::cvt_pk_bf16; using pg8::sigm; using pg8::silu_f;

#ifndef MK_DUP
#define MK_DUP 0
#endif
#ifndef MK_PER_PHASE
#define MK_PER_PHASE 0
#endif
constexpr int D = 1024, MT = 16896, MP = 16384, FFD = 2816;
constexpr int SEQ = 2048, BP = 8, BS = 128, LS = 4;
constexpr int LDS_BYTES = 147456;
constexpr size_t O_YP = 0, O_YS = 16777216, O_SSMP = 17301504, O_CONVP = 21495808, O_WKVP = 21692416, O_SHP = 22740992,
                 O_SSMS = 22757376, O_CONVS = 89866240, O_WKVS = 93011968, O_SHS = 109789184, O_TOTAL = 110051328;
constexpr size_t OFF_CTL = 0, OFF_H = 16384, OFF_HB = OFF_H + (size_t)MT * 1024 * 4, OFF_SS = OFF_HB + (size_t)MT * 1024 * 2, OFF_PB = OFF_SS + (size_t)17 * MT * 16 * 4,
                 OFF_VF = OFF_PB + (size_t)4 * MT * 256 * 2, OFF_W = OFF_VF + (size_t)MT * 1024 * 4;
constexpr size_t W_FU = 0, SZ_FU = (size_t)5632 * 1024;
constexpr size_t W_FD = W_FU + 8 * SZ_FU, SZ_FD = (size_t)1024 * 2816;
constexpr size_t W_PI = W_FD + 8 * SZ_FD, SZ_PI = (size_t)1024 * 256;
constexpr size_t W_PG = W_PI + 4 * SZ_PI, SZ_PG = (size_t)1024 * 1024;
constexpr size_t W_MI = W_PG + 4 * SZ_PG, SZ_MI = (size_t)6400 * 1024;
constexpr size_t W_MO = W_MI + 2 * SZ_MI, SZ_MO = (size_t)1024 * 2048;
constexpr size_t W_RK = W_MO + 2 * SZ_MO, SZ_RK = (size_t)3584 * 2048;
constexpr size_t W_RO = W_RK + 2 * SZ_RK, SZ_RO = (size_t)1024 * 1024;
constexpr size_t W_L2 = W_RO + 2 * SZ_RO, SZ_L2 = (size_t)4096 * 384;
constexpr size_t W_TOTAL = W_L2 + 2 * SZ_L2;
constexpr size_t OFF_SCR = OFF_W + W_TOTAL * 2;
constexpr size_t S_ACT = 0, S_PE = (size_t)MT * 2816 * 2, S_HB2 = S_PE + (size_t)MT * 1024 * 4;
constexpr size_t S_ZX = 0, S_DTR = (size_t)MT * 6144 * 2, S_YB = S_DTR + (size_t)MT * 32 * 4;
constexpr size_t SZF = (size_t)MT * 1024 * 4;
constexpr size_t S_A2 = 0, S_R = SZF, S_K = 2 * SZF, S_V2 = 3 * SZF, S_DD = 4 * SZF, S_AA = 5 * SZF, S_GG = 6 * SZF, S_VG = 7 * SZF, S_HID = 8 * SZF,
                 S_YB2 = S_HID + (size_t)MT * 384 * 2, S_END = S_YB2 + (size_t)MT * 1024 * 2;
constexpr size_t WS_NEED = OFF_SCR + S_END;

struct Params { const float* in[48]; float* out; unsigned char* ws; int ph_lo, ph_hi; };
typedef const unsigned char __attribute__((address_space(4)))* kptr_t;
struct KA {
    kptr_t p;
    __device__ __forceinline__ const float* in(int k) const { return *(const float* const __attribute__((address_space(4)))*)(p + 8 * k); }
    __device__ __forceinline__ float* out() const { return *(float* const __attribute__((address_space(4)))*)(p + 384); }
    __device__ __forceinline__ unsigned char* ws() const { return *(unsigned char* const __attribute__((address_space(4)))*)(p + 392); }
};
__device__ __forceinline__ KA karg() { KA k; k.p = (kptr_t)__builtin_amdgcn_kernarg_segment_ptr(); asm volatile("" : "+s"(k.p)); return k; }
static_assert(sizeof(Params) == 408, "kernarg layout");

#define LDS_WAIT() asm volatile("s_waitcnt lgkmcnt(0)" ::: "memory")
__device__ __forceinline__ float bf2f(bf16_t b) { return __builtin_bit_cast(float, (unsigned)b << 16); }
__device__ __forceinline__ f32x4 ld_bf4(const bf16_t* p) { const u32x2 w = *(const u32x2*)p; f32x4 r; r[0] = __builtin_bit_cast(float, w.x << 16); r[1] = __builtin_bit_cast(float, w.x & 0xffff0000u); r[2] = __builtin_bit_cast(float, w.y << 16); r[3] = __builtin_bit_cast(float, w.y & 0xffff0000u); return r; }
template <int CTRL> __device__ __forceinline__ float dppf(float x) { return __builtin_bit_cast(float, __builtin_amdgcn_update_dpp(0, __builtin_bit_cast(int, x), CTRL, 0xf, 0xf, true)); }
__device__ __forceinline__ float red4(float v) { v += dppf<0xB1>(v); v += dppf<0x4E>(v); return v; }
__device__ __forceinline__ float red8(float v) { v = red4(v); v += dppf<0x141>(v); return v; }
__device__ __forceinline__ float red16(float v) { v = red8(v); v += dppf<0x140>(v); return v; }
__device__ __forceinline__ float wave_sum(float v) {
#pragma unroll
    for (int o = 1; o < 64; o <<= 1) v += __shfl_xor(v, o);
    return v;
}
__device__ __forceinline__ float softplus_f(float y) { return fmaxf(y, 0.f) + log1pf(__expf(-fabsf(y))); }

#define XB_TMO      128
#define XB_XCNT(j)  (256  + 64 * (j))
#define XB_XSUB(j)  (1280 + 64 * (j))
#define XB_XGEN(j)  (2304 + 64 * (j))
#define XB_TOP      3328
#define XB_TOPGEN   3392
#define XCD_BAR_WORDS 3456
#define XB_SPIN_CAP (1u << 18)

__device__ __forceinline__ unsigned xb_ld(unsigned* p)              { return __hip_atomic_load(p, __ATOMIC_RELAXED, __HIP_MEMORY_SCOPE_AGENT); }
__device__ __forceinline__ unsigned xb_add(unsigned* p, unsigned v) { return __hip_atomic_fetch_add(p, v, __ATOMIC_RELAXED, __HIP_MEMORY_SCOPE_AGENT); }
__device__ __forceinline__ unsigned xb_xcc_id() { return (unsigned)__builtin_amdgcn_s_getreg((3 << 11) | 20) & 0xFu; }
#define XB_SPIN(cond, bar) do { unsigned _sp = 0; while (cond) { __builtin_amdgcn_s_sleep(1); \
    if ((++_sp & 255u) == 0u) { if (xb_ld(&(bar)[XB_TMO])) break; if (_sp > XB_SPIN_CAP) { atomicAdd(&(bar)[XB_TMO], 1u); break; } } } } while (0)

struct XcdBarrier {
    unsigned* bar; unsigned x;
    volatile LAS unsigned* st;
};

__device__ __forceinline__ XcdBarrier xcd_barrier_post(unsigned* bar, volatile LAS unsigned* st) {
    XcdBarrier b; b.bar = bar; b.x = xb_xcc_id(); b.st = st;
    if (threadIdx.x == 0) (void)xb_add(&bar[XB_XCNT(b.x)], 1u);
    return b;
}
__device__ __forceinline__ void xcd_barrier_complete(unsigned* bar, unsigned x, unsigned& nloc, unsigned& nx) {
    const unsigned G = gridDim.x * gridDim.y * gridDim.z;
    unsigned sum, cnt, mine, sp = 0u;
    for (;;) {
        sum = 0u; cnt = 0u; mine = 0u;
#pragma unroll
        for (unsigned j = 0; j < 16; ++j) { const unsigned c = xb_ld(&bar[XB_XCNT(j)]); sum += c; cnt += (c > 0u) ? 1u : 0u; mine = (j == x) ? c : mine; }
        if (sum == G) break;
        __builtin_amdgcn_s_sleep(1);
        if ((++sp & 255u) == 0u) { if (xb_ld(&bar[XB_TMO])) break; if (sp > XB_SPIN_CAP) { atomicAdd(&bar[XB_TMO], 1u); break; } }
    }
    nloc = mine > 0u ? mine : 1u; nx = cnt > 0u ? cnt : 1u;
}

__device__ __forceinline__ void xcd_barrier(const XcdBarrier& b) {
    asm volatile("s_waitcnt vmcnt(0)" ::: "memory");
    __syncthreads();
    if (threadIdx.x == 0) {
        unsigned* bar = b.bar;
        __builtin_amdgcn_s_waitcnt(0);
        unsigned nloc = b.st[0], nx = b.st[1];
        if (nloc == 0u) { xcd_barrier_complete(bar, b.x, nloc, nx); b.st[0] = nloc; b.st[1] = nx; }
        const unsigned old = xb_add(&bar[XB_XSUB(b.x)], 1u);
        const unsigned gen = old / nloc;
        if (old + 1u == (gen + 1u) * nloc) {
            __builtin_amdgcn_fence(__ATOMIC_RELEASE, "agent");
            asm volatile("s_waitcnt vmcnt(0)" ::: "memory");
            const unsigned og = xb_add(&bar[XB_TOP], 1u);
            const unsigned tg = og / nx;
            if (og + 1u == (tg + 1u) * nx) xb_add(&bar[XB_TOPGEN], 1u);
            else XB_SPIN(xb_ld(&bar[XB_TOPGEN]) == tg, bar);
            __builtin_amdgcn_fence(__ATOMIC_ACQUIRE, "agent");
            xb_add(&bar[XB_XGEN(b.x)], 1u);
            asm volatile("s_waitcnt vmcnt(0)" ::: "memory");
        } else {
            XB_SPIN(xb_ld(&bar[XB_XGEN(b.x)]) == gen, bar);
            __builtin_amdgcn_fence(__ATOMIC_ACQUIRE, "agent");
            asm volatile("s_waitcnt vmcnt(0)" ::: "memory");
        }
    }
    __syncthreads();
}

__device__ __forceinline__ void grid_bar(unsigned* cnt, unsigned target) {
    asm volatile("s_waitcnt vmcnt(0) lgkmcnt(0)" ::: "memory");
    __syncthreads();
    if (threadIdx.x == 0) {
        __builtin_amdgcn_fence(__ATOMIC_RELEASE, "agent");
        asm volatile("s_waitcnt vmcnt(0)" ::: "memory");
        __hip_atomic_fetch_add(cnt, 1u, __ATOMIC_RELAXED, __HIP_MEMORY_SCOPE_AGENT);
        while (__hip_atomic_load(cnt, __ATOMIC_RELAXED, __HIP_MEMORY_SCOPE_AGENT) < target) __builtin_amdgcn_s_sleep(2);
        __builtin_amdgcn_fence(__ATOMIC_ACQUIRE, "agent");
        asm volatile("s_waitcnt vmcnt(0)" ::: "memory");
    }
    __syncthreads();
}
__device__ __forceinline__ void tr_matrix(const float* __restrict__ W, int Ks, int Ns, bf16_t* dst, int ldd, int drow0, int dcol0, const float* __restrict__ kscale, int mode,
                                          int& base, int gw, int NGW, LAS float* scr, int lane) {
    const int nblk = Ns >> 5, nitems = (Ks >> 6) * nblk;
    const int first = (gw - (base % NGW) + NGW) % NGW;
    for (int it = first; it < nitems; it += NGW) {
        const int kb = it / nblk, nb = it - kb * nblk, k0 = kb * 64, n0 = nb * 32;
        float vv[32];
#pragma unroll
        for (int i = 0; i < 32; ++i) { const int kk = 2 * i + (lane >> 5); vv[i] = __builtin_nontemporal_load(W + (size_t)(k0 + kk) * Ns + n0 + (lane & 31)); }
        if (kscale) {
#pragma unroll
            for (int i = 0; i < 32; ++i) vv[i] *= kscale[k0 + 2 * i + (lane >> 5)]; }
#pragma unroll
        for (int i = 0; i < 32; ++i) scr[(2 * i + (lane >> 5)) * 33 + (lane & 31)] = vv[i];
        LDS_WAIT();
        int dr = n0;
        if (mode == 1) dr = n0 < 2816 ? (n0 / 128) * 256 + (n0 % 128) : ((n0 - 2816) / 128) * 256 + 128 + ((n0 - 2816) % 128);
        dr += drow0;
        const int c = lane & 7;
#pragma unroll
        for (int j = 0; j < 4; ++j) { const int n = (lane >> 3) + 8 * j; const LAS float* s = scr + (8 * c) * 33 + n;
            u32x4 o; o.x = cvt_pk_bf16(s[0 * 33], s[1 * 33]); o.y = cvt_pk_bf16(s[2 * 33], s[3 * 33]); o.z = cvt_pk_bf16(s[4 * 33], s[5 * 33]); o.w = cvt_pk_bf16(s[6 * 33], s[7 * 33]);
            *(u32x4*)(dst + (size_t)(dr + n) * ldd + dcol0 + k0 + 8 * c) = o; }
        LDS_WAIT();
    }
    base += nitems;
}

__device__ __forceinline__ void phase_prologue(const KA P, LAS unsigned char* lds) {
    int tid_ = threadIdx.x; asm volatile("" : "+v"(tid_)); const int tid = tid_, lane = tid & 63, wave = tid >> 6;
    const int gw = blockIdx.x * 8 + wave, NGW = gridDim.x * 8;
    LAS float* scr = (LAS float*)(lds + wave * 16384);
    bf16_t* WB = (bf16_t*)(P.ws() + OFF_W);
    int base = 0;
    for (int i = 0; i < 4; ++i) {
        tr_matrix(P.in(9) + (size_t)i * 1024 * 5632, 1024, 5632, WB + W_FU + (size_t)i * SZ_FU, 1024, 0, 0, P.in(8) + i * 1024, 1, base, gw, NGW, scr, lane);
        tr_matrix(P.in(13) + (size_t)i * 1024 * 5632, 1024, 5632, WB + W_FU + (size_t)(4 + i) * SZ_FU, 1024, 0, 0, P.in(12) + i * 1024, 1, base, gw, NGW, scr, lane);
        tr_matrix(P.in(10) + (size_t)i * 2816 * 1024, 2816, 1024, WB + W_FD + (size_t)i * SZ_FD, 2816, 0, 0, nullptr, 0, base, gw, NGW, scr, lane);
        tr_matrix(P.in(14) + (size_t)i * 2816 * 1024, 2816, 1024, WB + W_FD + (size_t)(4 + i) * SZ_FD, 2816, 0, 0, nullptr, 0, base, gw, NGW, scr, lane);
        tr_matrix(P.in(16) + (size_t)i * 256 * 1024, 256, 1024, WB + W_PI + (size_t)i * SZ_PI, 256, 0, 0, nullptr, 0, base, gw, NGW, scr, lane);
        tr_matrix(P.in(17) + (size_t)i * 1024 * 1024, 1024, 1024, WB + W_PG + (size_t)i * SZ_PG, 1024, 0, 0, P.in(15) + i * 1024, 0, base, gw, NGW, scr, lane);
    }
    for (int j = 0; j < 2; ++j) {
        tr_matrix(P.in(19) + (size_t)j * 1024 * 6176, 1024, 6176, WB + W_MI + (size_t)j * SZ_MI, 1024, 0, 0, P.in(11) + (2 * j) * 1024, 0, base, gw, NGW, scr, lane);
        tr_matrix(P.in(26) + (size_t)j * 2048 * 1024, 2048, 1024, WB + W_MO + (size_t)j * SZ_MO, 2048, 0, 0, P.in(25) + j * 2048, 0, base, gw, NGW, scr, lane);
        bf16_t* rk = WB + W_RK + (size_t)j * SZ_RK; const float* mu = P.in(27) + (size_t)j * 6 * 1024;
        tr_matrix(P.in(28) + (size_t)j * 1024 * 1024, 1024, 1024, rk, 2048, 0, 0, nullptr, 0, base, gw, NGW, scr, lane);
        tr_matrix(P.in(28) + (size_t)j * 1024 * 1024, 1024, 1024, rk, 2048, 0, 1024, mu + 0 * 1024, 0, base, gw, NGW, scr, lane);
        tr_matrix(P.in(29) + (size_t)j * 1024 * 1024, 1024, 1024, rk, 2048, 1024, 0, nullptr, 0, base, gw, NGW, scr, lane);
        tr_matrix(P.in(29) + (size_t)j * 1024 * 1024, 1024, 1024, rk, 2048, 1024, 1024, mu + 2 * 1024, 0, base, gw, NGW, scr, lane);
        tr_matrix(P.in(30) + (size_t)j * 1024 * 1024, 1024, 1024, rk, 2048, 2048, 0, nullptr, 0, base, gw, NGW, scr, lane);
        tr_matrix(P.in(30) + (size_t)j * 1024 * 1024, 1024, 1024, rk, 2048, 2048, 1024, mu + 3 * 1024, 0, base, gw, NGW, scr, lane);
        tr_matrix(P.in(33) + (size_t)j * 1024 * 64, 1024, 64, rk, 2048, 3072, 0, nullptr, 0, base, gw, NGW, scr, lane);
        tr_matrix(P.in(33) + (size_t)j * 1024 * 64, 1024, 64, rk, 2048, 3072, 1024, mu + 1 * 1024, 0, base, gw, NGW, scr, lane);
        tr_matrix(P.in(36) + (size_t)j * 1024 * 64, 1024, 64, rk, 2048, 3136, 0, nullptr, 0, base, gw, NGW, scr, lane);
        tr_matrix(P.in(36) + (size_t)j * 1024 * 64, 1024, 64, rk, 2048, 3136, 1024, mu + 4 * 1024, 0, base, gw, NGW, scr, lane);
        tr_matrix(P.in(38) + (size_t)j * 1024 * 160, 1024, 160, rk, 2048, 3200, 0, nullptr, 0, base, gw, NGW, scr, lane);
        tr_matrix(P.in(38) + (size_t)j * 1024 * 160, 1024, 160, rk, 2048, 3200, 1024, mu + 5 * 1024, 0, base, gw, NGW, scr, lane);
        if (j == 1) {
            tr_matrix(P.in(46), 1024, 32, rk, 2048, 3360, 0, nullptr, 0, base, gw, NGW, scr, lane);
            tr_matrix(P.in(46), 1024, 32, rk, 2048, 3360, 1024, mu + 3 * 1024, 0, base, gw, NGW, scr, lane);
        }
        tr_matrix(P.in(31) + (size_t)j * 1024 * 1024, 1024, 1024, WB + W_RO + (size_t)j * SZ_RO, 1024, 0, 0, nullptr, 0, base, gw, NGW, scr, lane);
    }
    const size_t gt = (size_t)blockIdx.x * 512 + tid, NT = (size_t)gridDim.x * 512;
    for (size_t e = gt; e < (size_t)2 * 384 * 4096; e += NT) {
        const int n = (int)(e & 4095), k = (int)((e >> 12) % 384), j = (int)(e / ((size_t)384 * 4096));
        const int q = n >> 10, c = n & 1023; float v = 0.f;
        if (q == 0) { if (k < 64) v = P.in(34)[((size_t)j * 64 + k) * 1024 + c]; }
        else if (q == 1) { if (k >= 64 && k < 128) v = P.in(37)[((size_t)j * 64 + (k - 64)) * 1024 + c]; }
        else if (q == 2) { if (k >= 128 && k < 288) v = P.in(39)[((size_t)j * 160 + (k - 128)) * 1024 + c]; }
        else { if (k >= 288 && k < 320 && j == 1) v = P.in(47)[(size_t)(k - 288) * 1024 + c]; }
        WB[W_L2 + (size_t)j * SZ_L2 + (size_t)n * 384 + k] = (bf16_t)(cvt_pk_bf16(v, 0.f) & 0xffffu);
    }
    bf16_t* pb = (bf16_t*)(P.ws() + OFF_PB);
    for (size_t e = gt; e < (size_t)4 * MT * 64; e += NT) {
        const int c4 = (int)(e & 63); const size_t im = e >> 6; const int i = (int)(im / MT), m = (int)(im % MT);
        const float* src = m < MP ? P.in(2) + ((size_t)i * MP + m) * 256 : P.in(3) + ((size_t)i * 512 + (m - MP)) * 256;
        const f32x4 v = __builtin_nontemporal_load((const f32x4*)(src + c4 * 4));
        u32x2 w; w.x = cvt_pk_bf16(v[0], v[1]); w.y = cvt_pk_bf16(v[2], v[3]);
        *(u32x2*)(pb + im * 256 + c4 * 4) = w;
    }
    float* ss = (float*)(P.ws() + OFF_SS);
    bf16_t* hb = (bf16_t*)(P.ws() + OFF_HB);
    for (int m = gw; m < MT; m += NGW) {
        const float* src = m < MP ? P.in(0) + (size_t)m * 1024 : P.in(1) + (size_t)(m - MP) * 1024;
        float q = 0.f;
#pragma unroll
        for (int jj = 0; jj < 4; ++jj) { const int c = 4 * lane + 256 * jj; const f32x4 v = __builtin_nontemporal_load((const f32x4*)(src + c));
            u32x2 w; w.x = cvt_pk_bf16(v[0], v[1]); w.y = cvt_pk_bf16(v[2], v[3]); *(u32x2*)(hb + (size_t)m * 1024 + c) = w;
            const float r0 = __builtin_bit_cast(float, w.x << 16), r1 = __builtin_bit_cast(float, w.x & 0xffff0000u), r2 = __builtin_bit_cast(float, w.y << 16), r3 = __builtin_bit_cast(float, w.y & 0xffff0000u);
            q += (r0 * r0 + r1 * r1) + (r2 * r2 + r3 * r3); }
        q = wave_sum(q);
        if (lane < 16) ss[(size_t)m * 16 + lane] = lane == 0 ? q : 0.f;
    }
}

template <bool PROMPT>
__device__ __forceinline__ void ssd_unit(const KA P, int j, int row0, int hd, const float* st0, float* stout, const float* cb0, LAS unsigned char* lds) {
    constexpr int T = 32, L = PROMPT ? SEQ : LS, NW = T / 2 + 3;
    int tid_ = threadIdx.x; asm volatile("" : "+v"(tid_)); const int tid = tid_;
    typedef float f32x2 __attribute__((ext_vector_type(2)));
    LAS float* xs = (LAS float*)lds;
    LAS float* Bs = xs + T * 64;
    LAS float* Cs = Bs + T * 128;
    LAS float* dts = Cs + T * 128;
    LAS float* dAs = dts + T;
    LAS float* ys = dAs + T;
    const bf16_t* zx = (const bf16_t*)(P.ws() + OFF_SCR + S_ZX);
    const float* dtraw = (const float*)(P.ws() + OFF_SCR + S_DTR);
    bf16_t* yb = (bf16_t*)(P.ws() + OFF_SCR + S_YB);
    const float* cw = P.in(20) + (size_t)j * 4 * 4096; const float* cbias = P.in(21) + (size_t)j * 4096;
    const int g = hd >> 2;
    const float Ah = -__expf(P.in(23)[j * 32 + hd]), Dh = P.in(24)[j * 32 + hd], dtb = P.in(22)[j * 32 + hd];
    const int p = tid >> 3, nq = tid & 7;
    f32x2 S2[8];
    if (!PROMPT) {
#pragma unroll
        for (int q = 0; q < 4; ++q) { const f32x4 v = __builtin_nontemporal_load((const f32x4*)(st0 + p * 128 + 32 * q + 4 * nq)); S2[2 * q] = (f32x2){v[0], v[1]}; S2[2 * q + 1] = (f32x2){v[2], v[3]}; }
    } else {
#pragma unroll
        for (int q = 0; q < 8; ++q) S2[q] = (f32x2){0.f, 0.f};
    }
    const int cp = tid % 160, th = tid / 160, c0 = 2 * cp;
    const int chn = c0 < 64 ? hd * 64 + c0 : (c0 < 192 ? 2048 + g * 128 + (c0 - 64) : 3072 + g * 128 + (c0 - 192));
    LAS float* sdst = c0 < 64 ? xs + c0 : (c0 < 192 ? Bs + (c0 - 64) : Cs + (c0 - 192));
    const int sstr = c0 < 64 ? 64 : 128;
    float cwr[4][2], cbr[2];
#pragma unroll
    for (int k = 0; k < 4; ++k) { const f32x2 wv = *(const f32x2*)(cw + k * 4096 + chn); cwr[k][0] = wv.x; cwr[k][1] = wv.y; }
    { const f32x2 bv = *(const f32x2*)(cbias + chn); cbr[0] = bv.x; cbr[1] = bv.y; }
    if (PROMPT) {
        unsigned zw[NW]; float dtn = 0.f;
        const int tb = th * (T / 2);
        const bool stg = tid < 320, dtt = tid >= 320 && tid < 320 + T;
        if (stg) {
#pragma unroll
            for (int r = 0; r < NW; ++r) { const int tt = tb - 3 + r; zw[r] = *(const unsigned*)(zx + (size_t)(row0 + (tt < 0 ? 0 : tt)) * 6144 + 2048 + chn); }
        }
        if (dtt) dtn = dtraw[(size_t)(row0 + tid - 320) * 32 + hd];
        for (int t0 = 0; t0 < L; t0 += T) {
            __syncthreads();
            if (dtt) { const float dtv = softplus_f(dtn + dtb); dts[tid - 320] = dtv; dAs[tid - 320] = __expf(dtv * Ah); }
            if (stg) {
                f32x2 win[NW];
#pragma unroll
                for (int r = 0; r < NW; ++r) { f32x2 zf; zf.x = __builtin_bit_cast(float, zw[r] << 16); zf.y = __builtin_bit_cast(float, zw[r] & 0xffff0000u);
                    win[r] = (t0 + tb - 3 + r) >= 0 ? zf : (f32x2){0.f, 0.f}; }
#pragma unroll
                for (int r = 0; r < T / 2; ++r) {
                    float v0 = cbr[0] + cwr[0][0] * win[r].x + cwr[1][0] * win[r + 1].x + cwr[2][0] * win[r + 2].x + cwr[3][0] * win[r + 3].x;
                    float v1 = cbr[1] + cwr[0][1] * win[r].y + cwr[1][1] * win[r + 1].y + cwr[2][1] * win[r + 2].y + cwr[3][1] * win[r + 3].y;
                    *(LAS f32x2*)(sdst + (tb + r) * sstr) = (f32x2){silu_f(v0), silu_f(v1)}; }
            }
            if (t0 + T < L) {
                if (stg) {
#pragma unroll
                    for (int r = 0; r < NW; ++r) zw[r] = *(const unsigned*)(zx + (size_t)(row0 + t0 + T + tb - 3 + r) * 6144 + 2048 + chn);
                }
                if (dtt) dtn = dtraw[(size_t)(row0 + t0 + T + tid - 320) * 32 + hd];
            }
            __syncthreads();
#pragma unroll 4
            for (int t = 0; t < T; ++t) {
                const float x = xs[t * 64 + p], dA = dAs[t], xdt = x * dts[t];
                f32x2 acc2 = (f32x2){0.f, 0.f};
#pragma unroll
                for (int q = 0; q < 4; ++q) {
                    const f32x4 b4 = *(const LAS f32x4*)(Bs + t * 128 + 32 * q + 4 * nq), c4 = *(const LAS f32x4*)(Cs + t * 128 + 32 * q + 4 * nq);
                    S2[2 * q] = S2[2 * q] * dA + (f32x2){b4[0], b4[1]} * xdt; acc2 += S2[2 * q] * (f32x2){c4[0], c4[1]};
                    S2[2 * q + 1] = S2[2 * q + 1] * dA + (f32x2){b4[2], b4[3]} * xdt; acc2 += S2[2 * q + 1] * (f32x2){c4[2], c4[3]};
                }
                float acc = red8(acc2.x + acc2.y);
                if (nq == 0) ys[t * 64 + p] = acc + Dh * x;
            }
            __syncthreads();
            for (int e = tid; e < T * 32; e += 512) { const int t = e >> 5, pp = (e & 31) * 2;
                *(unsigned*)(yb + (size_t)(row0 + t0 + t) * 2048 + hd * 64 + pp) = cvt_pk_bf16(ys[t * 64 + pp], ys[t * 64 + pp + 1]); }
        }
    } else {
        constexpr int nt = LS, nh = nt / 2;
        const int tb = th * nh;
        __syncthreads();
        if (tid >= 320 && tid - 320 < nt) { const int t = tid - 320; const float dtv = softplus_f(dtraw[(size_t)(row0 + t) * 32 + hd] + dtb); dts[t] = dtv; dAs[t] = __expf(dtv * Ah); }
        if (tid < 320) {
#pragma unroll
            for (int r0 = 0; r0 < nh; ++r0) { const int t = tb + r0; float v0 = cbr[0], v1 = cbr[1];
#pragma unroll
                for (int k = 0; k < 4; ++k) { const int tt = t - 3 + k; const int zr = tt < 0 ? 0 : tt;
                    const unsigned zv = *(const unsigned*)(zx + (size_t)(row0 + zr) * 6144 + 2048 + chn);
                    const int cr = tt < 0 ? 3 + tt : 2;
                    const f32x2 cv = *(const f32x2*)(cb0 + cr * 4096 + chn);
                    f32x2 zf; zf.x = __builtin_bit_cast(float, zv << 16); zf.y = __builtin_bit_cast(float, zv & 0xffff0000u);
                    const f32x2 xin = tt >= 0 ? zf : cv;
                    v0 += cwr[k][0] * xin.x; v1 += cwr[k][1] * xin.y; }
                *(LAS f32x2*)(sdst + t * sstr) = (f32x2){silu_f(v0), silu_f(v1)}; }
        }
        __syncthreads();
#pragma unroll
        for (int t = 0; t < nt; ++t) {
            const float x = xs[t * 64 + p], dA = dAs[t], xdt = x * dts[t];
            f32x2 acc2 = (f32x2){0.f, 0.f};
#pragma unroll
            for (int q = 0; q < 4; ++q) {
                const f32x4 b4 = *(const LAS f32x4*)(Bs + t * 128 + 32 * q + 4 * nq), c4 = *(const LAS f32x4*)(Cs + t * 128 + 32 * q + 4 * nq);
                S2[2 * q] = S2[2 * q] * dA + (f32x2){b4[0], b4[1]} * xdt; acc2 += S2[2 * q] * (f32x2){c4[0], c4[1]};
                S2[2 * q + 1] = S2[2 * q + 1] * dA + (f32x2){b4[2], b4[3]} * xdt; acc2 += S2[2 * q + 1] * (f32x2){c4[2], c4[3]};
            }
            float acc = red8(acc2.x + acc2.y);
            if (nq == 0) ys[t * 64 + p] = acc + Dh * x;
        }
        __syncthreads();
        for (int e = tid; e < nt * 32; e += 512) { const int t = e >> 5, pp = (e & 31) * 2;
            *(unsigned*)(yb + (size_t)(row0 + t) * 2048 + hd * 64 + pp) = cvt_pk_bf16(ys[t * 64 + pp], ys[t * 64 + pp + 1]); }
    }
#pragma unroll
    for (int q = 0; q < 4; ++q) __builtin_nontemporal_store((f32x4){S2[2 * q].x, S2[2 * q].y, S2[2 * q + 1].x, S2[2 * q + 1].y}, (f32x4*)(stout + p * 128 + 32 * q + 4 * nq));
}

#ifndef MK_SSD_MFMA
#define MK_SSD_MFMA 1
#endif
__device__ __forceinline__ void ssd_unit_mfma(const KA P, int j, int row0, int hd, float* stout, LAS unsigned char* lds) {
    constexpr int Q = 64, NCH = SEQ / Q, RS = 272, RT = 144;
    int tid_ = threadIdx.x; asm volatile("" : "+v"(tid_)); const int tid = tid_, lane = tid & 63, wid = tid >> 6, fr = lane & 15, fq = lane >> 4;
    typedef float f32x2 __attribute__((ext_vector_type(2)));
    typedef short bf16x8_t __attribute__((ext_vector_type(8)));
    LAS unsigned char* Cs = lds;
    LAS unsigned char* Bs = Cs + 64 * RS;
    LAS unsigned char* Sb = Bs + 64 * RS;
    LAS unsigned char* Bt = Sb + 64 * RS;
    LAS unsigned char* Xt = Bt + 128 * RT;
    LAS unsigned char* Xst = Xt + 64 * RT;
    LAS unsigned char* Mm = Xst + 64 * RT;
    LAS float* ys = (LAS float*)(Mm + 64 * RT);
    LAS float* dtb_ = ys + 64 * 64;
    LAS float* dtq = dtb_ + 2 * 4 * 64;
    const bf16_t* zx = (const bf16_t*)(P.ws() + OFF_SCR + S_ZX);
    const float* dtraw = (const float*)(P.ws() + OFF_SCR + S_DTR);
    bf16_t* yb = (bf16_t*)(P.ws() + OFF_SCR + S_YB);
    const float* cw = P.in(20) + (size_t)j * 4 * 4096; const float* cbias = P.in(21) + (size_t)j * 4096;
    const int g = hd >> 2;
    const float Ah = -__expf(P.in(23)[j * 32 + hd]), Dh = P.in(24)[j * 32 + hd], dtbias = P.in(22)[j * 32 + hd];
    int chn[2], c0s[2], qts[2]; float cwr[2][4][2], cbr[2][2];
#pragma unroll
    for (int s = 0; s < 2; ++s) { const int it = tid + 512 * s; const int cp = it % 160; qts[s] = it / 160; const int c0 = 2 * cp; c0s[s] = c0;
        chn[s] = c0 < 64 ? hd * 64 + c0 : (c0 < 192 ? 2048 + g * 128 + (c0 - 64) : 3072 + g * 128 + (c0 - 192));
#pragma unroll
        for (int k = 0; k < 4; ++k) { const f32x2 wv = *(const f32x2*)(cw + k * 4096 + chn[s]); cwr[s][k][0] = wv.x; cwr[s][k][1] = wv.y; }
        const f32x2 bv = *(const f32x2*)(cbias + chn[s]); cbr[s][0] = bv.x; cbr[s][1] = bv.y; }
    const bool has2 = tid < 128;
    unsigned zw[2][19]; float dtn = 0.f;
    for (int e = tid; e < 64 * RS / 4; e += 512) ((LAS unsigned*)Sb)[e] = 0u;
#pragma unroll
    for (int s = 0; s < 2; ++s) if (s == 0 || has2) {
#pragma unroll
        for (int r = 0; r < 19; ++r) { const int tt = 16 * qts[s] - 3 + r; zw[s][r] = *(const unsigned*)(zx + (size_t)(row0 + (tt < 0 ? 0 : tt)) * 6144 + 2048 + chn[s]); } }
    if (wid == 7) dtn = dtraw[(size_t)(row0 + lane) * 32 + hd];
    f32x4 accS[4];
#pragma unroll
    for (int k = 0; k < 4; ++k) accS[k] = (f32x4){0.f, 0.f, 0.f, 0.f};
#define SSD_DTPREFIX(cbuf) do { if (wid == 7) { const float dtv = softplus_f(dtn + dtbias); float a = dtv * Ah; \
        _Pragma("unroll") for (int o = 1; o < 64; o <<= 1) { const float up = __shfl_up(a, o); if (lane >= o) a += up; } \
        const float aQ = __shfl(a, 63); LAS float* d = dtb_ + (cbuf) * 256; d[lane] = a; d[64 + lane] = __expf(a); d[128 + lane] = __expf(aQ - a) * dtv; d[192 + lane] = dtv; \
        if (lane == 0) dtq[(cbuf)] = __expf(aQ); } } while (0)
    SSD_DTPREFIX(0);
    __syncthreads();
    for (int c = 0; c < NCH; ++c) {
        const int t0 = c * Q; LAS float* dcur = dtb_ + (c & 1) * 256;
#pragma unroll
        for (int s = 0; s < 2; ++s) if (s == 0 || has2) {
            const int c0 = c0s[s], qt = qts[s];
            f32x2 win[19];
#pragma unroll
            for (int r = 0; r < 19; ++r) { f32x2 zf; zf.x = __builtin_bit_cast(float, zw[s][r] << 16); zf.y = __builtin_bit_cast(float, zw[s][r] & 0xffff0000u);
                win[r] = (t0 + 16 * qt - 3 + r) >= 0 ? zf : (f32x2){0.f, 0.f}; }
            float v0[16], v1[16];
#pragma unroll
            for (int r = 0; r < 16; ++r) {
                const float a0 = cbr[s][0] + cwr[s][0][0] * win[r].x + cwr[s][1][0] * win[r + 1].x + cwr[s][2][0] * win[r + 2].x + cwr[s][3][0] * win[r + 3].x;
                const float a1 = cbr[s][1] + cwr[s][0][1] * win[r].y + cwr[s][1][1] * win[r + 1].y + cwr[s][2][1] * win[r + 2].y + cwr[s][3][1] * win[r + 3].y;
                v0[r] = a0 * __builtin_amdgcn_rcpf(1.f + __expf(-a0)); v1[r] = a1 * __builtin_amdgcn_rcpf(1.f + __expf(-a1)); }
            if (c0 < 64) {
                u32x4 w;
                w.x = cvt_pk_bf16(v0[0], v0[1]); w.y = cvt_pk_bf16(v0[2], v0[3]); w.z = cvt_pk_bf16(v0[4], v0[5]); w.w = cvt_pk_bf16(v0[6], v0[7]); *(LAS u32x4*)(Xt + c0 * RT + qt * 32) = w;
                w.x = cvt_pk_bf16(v0[8], v0[9]); w.y = cvt_pk_bf16(v0[10], v0[11]); w.z = cvt_pk_bf16(v0[12], v0[13]); w.w = cvt_pk_bf16(v0[14], v0[15]); *(LAS u32x4*)(Xt + c0 * RT + qt * 32 + 16) = w;
                w.x = cvt_pk_bf16(v1[0], v1[1]); w.y = cvt_pk_bf16(v1[2], v1[3]); w.z = cvt_pk_bf16(v1[4], v1[5]); w.w = cvt_pk_bf16(v1[6], v1[7]); *(LAS u32x4*)(Xt + (c0 + 1) * RT + qt * 32) = w;
                w.x = cvt_pk_bf16(v1[8], v1[9]); w.y = cvt_pk_bf16(v1[10], v1[11]); w.z = cvt_pk_bf16(v1[12], v1[13]); w.w = cvt_pk_bf16(v1[14], v1[15]); *(LAS u32x4*)(Xt + (c0 + 1) * RT + qt * 32 + 16) = w;
                float s0[16], s1[16];
#pragma unroll
                for (int r = 0; r < 16; ++r) { const float w1 = dcur[128 + 16 * qt + r]; s0[r] = v0[r] * w1; s1[r] = v1[r] * w1; }
                w.x = cvt_pk_bf16(s0[0], s0[1]); w.y = cvt_pk_bf16(s0[2], s0[3]); w.z = cvt_pk_bf16(s0[4], s0[5]); w.w = cvt_pk_bf16(s0[6], s0[7]); *(LAS u32x4*)(Xst + c0 * RT + qt * 32) = w;
                w.x = cvt_pk_bf16(s0[8], s0[9]); w.y = cvt_pk_bf16(s0[10], s0[11]); w.z = cvt_pk_bf16(s0[12], s0[13]); w.w = cvt_pk_bf16(s0[14], s0[15]); *(LAS u32x4*)(Xst + c0 * RT + qt * 32 + 16) = w;
                w.x = cvt_pk_bf16(s1[0], s1[1]); w.y = cvt_pk_bf16(s1[2], s1[3]); w.z = cvt_pk_bf16(s1[4], s1[5]); w.w = cvt_pk_bf16(s1[6], s1[7]); *(LAS u32x4*)(Xst + (c0 + 1) * RT + qt * 32) = w;
                w.x = cvt_pk_bf16(s1[8], s1[9]); w.y = cvt_pk_bf16(s1[10], s1[11]); w.z = cvt_pk_bf16(s1[12], s1[13]); w.w = cvt_pk_bf16(s1[14], s1[15]); *(LAS u32x4*)(Xst + (c0 + 1) * RT + qt * 32 + 16) = w;
            } else {
                const bool isB = c0 < 192; const int n = isB ? c0 - 64 : c0 - 192; LAS unsigned char* nat = isB ? Bs : Cs;
#pragma unroll
                for (int r = 0; r < 16; ++r) *(LAS unsigned*)(nat + (16 * qt + r) * RS + n * 2) = cvt_pk_bf16(v0[r], v1[r]);
                if (isB) { u32x4 w;
                    w.x = cvt_pk_bf16(v0[0], v0[1]); w.y = cvt_pk_bf16(v0[2], v0[3]); w.z = cvt_pk_bf16(v0[4], v0[5]); w.w = cvt_pk_bf16(v0[6], v0[7]); *(LAS u32x4*)(Bt + n * RT + qt * 32) = w;
                    w.x = cvt_pk_bf16(v0[8], v0[9]); w.y = cvt_pk_bf16(v0[10], v0[11]); w.z = cvt_pk_bf16(v0[12], v0[13]); w.w = cvt_pk_bf16(v0[14], v0[15]); *(LAS u32x4*)(Bt + n * RT + qt * 32 + 16) = w;
                    w.x = cvt_pk_bf16(v1[0], v1[1]); w.y = cvt_pk_bf16(v1[2], v1[3]); w.z = cvt_pk_bf16(v1[4], v1[5]); w.w = cvt_pk_bf16(v1[6], v1[7]); *(LAS u32x4*)(Bt + (n + 1) * RT + qt * 32) = w;
                    w.x = cvt_pk_bf16(v1[8], v1[9]); w.y = cvt_pk_bf16(v1[10], v1[11]); w.z = cvt_pk_bf16(v1[12], v1[13]); w.w = cvt_pk_bf16(v1[14], v1[15]); *(LAS u32x4*)(Bt + (n + 1) * RT + qt * 32 + 16) = w; }
            }
        }
        if (c + 1 < NCH) {
#pragma unroll
            for (int s = 0; s < 2; ++s) if (s == 0 || has2) {
#pragma unroll
                for (int r = 0; r < 19; ++r) zw[s][r] = *(const unsigned*)(zx + (size_t)(row0 + t0 + Q + 16 * qts[s] - 3 + r) * 6144 + 2048 + chn[s]); }
            if (wid == 7) dtn = dtraw[(size_t)(row0 + t0 + Q + lane) * 32 + hd];
        }
        __syncthreads();
        { const int it = wid >> 1;
#pragma unroll
          for (int u = 0; u < 2; ++u) { const int jt = (wid & 1) * 2 + u;
            f32x4 gacc = (f32x4){0.f, 0.f, 0.f, 0.f};
            if (jt <= it) {
#pragma unroll
                for (int ks = 0; ks < 4; ++ks) { const bf16x8_t ca = *(const LAS bf16x8_t*)(Cs + (16 * it + fr) * RS + (32 * ks + 8 * fq) * 2), bb = *(const LAS bf16x8_t*)(Bs + (16 * jt + fr) * RS + (32 * ks + 8 * fq) * 2);
                    gacc = __builtin_amdgcn_mfma_f32_16x16x32_bf16(ca, bb, gacc, 0, 0, 0); }
            }
            const int jj = 16 * jt + fr; const float aj = dcur[jj], dj = dcur[192 + jj];
#pragma unroll
            for (int r = 0; r < 4; ++r) { const int ii = 16 * it + 4 * fq + r; const float ai = dcur[ii];
                const float mv = (jj <= ii) ? gacc[r] * __expf(ai - aj) * dj : 0.f;
                *(LAS unsigned short*)(Mm + ii * RT + jj * 2) = (unsigned short)(cvt_pk_bf16(mv, 0.f) & 0xffffu); }
          } }
        __syncthreads();
        { const int it = wid >> 1;
#pragma unroll
          for (int u = 0; u < 2; ++u) { const int pt = (wid & 1) * 2 + u;
            f32x4 ya = (f32x4){0.f, 0.f, 0.f, 0.f}, yi = (f32x4){0.f, 0.f, 0.f, 0.f};
#pragma unroll
            for (int ks = 0; ks < 2; ++ks) if (32 * ks <= 16 * it + 15) { const bf16x8_t ma = *(const LAS bf16x8_t*)(Mm + (16 * it + fr) * RT + (32 * ks + 8 * fq) * 2), xb = *(const LAS bf16x8_t*)(Xt + (16 * pt + fr) * RT + (32 * ks + 8 * fq) * 2);
                ya = __builtin_amdgcn_mfma_f32_16x16x32_bf16(ma, xb, ya, 0, 0, 0); }
#pragma unroll
            for (int ks = 0; ks < 4; ++ks) { const bf16x8_t ca = *(const LAS bf16x8_t*)(Cs + (16 * it + fr) * RS + (32 * ks + 8 * fq) * 2), sb = *(const LAS bf16x8_t*)(Sb + (16 * pt + fr) * RS + (32 * ks + 8 * fq) * 2);
                yi = __builtin_amdgcn_mfma_f32_16x16x32_bf16(ca, sb, yi, 0, 0, 0); }
            const int pp = 16 * pt + fr;
#pragma unroll
            for (int r = 0; r < 4; ++r) { const int ii = 16 * it + 4 * fq + r;
                const float xv = bf2f(*(const LAS unsigned short*)(Xt + pp * RT + ii * 2));
                ys[ii * 64 + pp] = ya[r] + dcur[64 + ii] * yi[r] + Dh * xv; }
          } }
        { const int pt = wid >> 1; const float eq = dtq[c & 1];
#pragma unroll
          for (int k = 0; k < 4; ++k) { const int nt = (wid & 1) * 4 + k;
            accS[k] = accS[k] * eq;
#pragma unroll
            for (int ks = 0; ks < 2; ++ks) { const bf16x8_t xa = *(const LAS bf16x8_t*)(Xst + (16 * pt + fr) * RT + (32 * ks + 8 * fq) * 2), bb = *(const LAS bf16x8_t*)(Bt + (16 * nt + fr) * RT + (32 * ks + 8 * fq) * 2);
                accS[k] = __builtin_amdgcn_mfma_f32_16x16x32_bf16(xa, bb, accS[k], 0, 0, 0); }
          } }
        if (c + 1 < NCH) SSD_DTPREFIX((c + 1) & 1);
        __syncthreads();
        { const int pt = wid >> 1;
#pragma unroll
          for (int k = 0; k < 4; ++k) { const int nn = 16 * ((wid & 1) * 4 + k) + fr;
#pragma unroll
            for (int r = 0; r < 4; ++r) *(LAS unsigned short*)(Sb + (16 * pt + 4 * fq + r) * RS + nn * 2) = (unsigned short)(cvt_pk_bf16(accS[k][r], 0.f) & 0xffffu); } }
        { const int t = tid >> 3, p8 = (tid & 7) * 8; const f32x4 ya = *(const LAS f32x4*)(ys + t * 64 + p8), yc = *(const LAS f32x4*)(ys + t * 64 + p8 + 4);
          u32x4 w; w.x = cvt_pk_bf16(ya[0], ya[1]); w.y = cvt_pk_bf16(ya[2], ya[3]); w.z = cvt_pk_bf16(yc[0], yc[1]); w.w = cvt_pk_bf16(yc[2], yc[3]);
          *(u32x4*)(yb + (size_t)(row0 + t0 + t) * 2048 + hd * 64 + p8) = w; }
    }
#undef SSD_DTPREFIX
    { const int pt = wid >> 1;
#pragma unroll
      for (int k = 0; k < 4; ++k) { const int nn = 16 * ((wid & 1) * 4 + k) + fr;
#pragma unroll
        for (int r = 0; r < 4; ++r) __builtin_nontemporal_store(accS[k][r], stout + (16 * pt + 4 * fq + r) * 128 + nn); } }
    __syncthreads();
}

__device__ __forceinline__ void phase_ssd(const KA P, int j, LAS unsigned char* lds) {
    {
        const bf16_t* zx = (const bf16_t*)(P.ws() + OFF_SCR + S_ZX);
        int tid2_ = threadIdx.x; asm volatile("" : "+v"(tid2_)); const size_t gt = (size_t)blockIdx.x * 512 + tid2_, NT = (size_t)gridDim.x * 512;
        for (size_t e = gt; e < (size_t)(BP + BS) * 3 * 4096; e += NT) {
            const int ch = (int)(e & 4095), r = (int)((e >> 12) % 3), b = (int)(e / (3 * 4096));
            if (b < BP) P.out()[O_CONVP + ((size_t)(j * BP + b) * 3 + r) * 4096 + ch] = bf2f(zx[(size_t)(b * SEQ + SEQ - 3 + r) * 6144 + 2048 + ch]);
            else { const int bs = b - BP; P.out()[O_CONVS + ((size_t)(j * BS + bs) * 3 + r) * 4096 + ch] = bf2f(zx[(size_t)(MP + bs * LS + LS - 3 + r) * 6144 + 2048 + ch]); }
        }
    }
    for (int u = blockIdx.x; u < 256 + 4096; u += gridDim.x) {
        if (u < 256) { const int b = u >> 5, hd = u & 31;
            if (MK_SSD_MFMA) ssd_unit_mfma(P, j, b * SEQ, hd, P.out() + O_SSMP + ((size_t)(j * BP + b) * 32 + hd) * 8192, lds);
            else ssd_unit<true>(P, j, b * SEQ, hd, nullptr, P.out() + O_SSMP + ((size_t)(j * BP + b) * 32 + hd) * 8192, nullptr, lds);
        } else { const int b = (u - 256) >> 5, hd = u & 31;
            ssd_unit<false>(P, j, MP + b * LS, hd, P.in(4) + ((size_t)(j * BS + b) * 32 + hd) * 8192, P.out() + O_SSMS + ((size_t)(j * BS + b) * 32 + hd) * 8192,
                     P.in(5) + (size_t)(j * BS + b) * 3 * 4096, lds);
        }
    }
}
__device__ __forceinline__ void phase_mgate(const KA P) {
    int tid_ = threadIdx.x; asm volatile("" : "+v"(tid_)); const int lane = tid_ & 63, gw = blockIdx.x * 8 + (tid_ >> 6), NGW = gridDim.x * 8;
    const bf16_t* zx = (const bf16_t*)(P.ws() + OFF_SCR + S_ZX);
    bf16_t* yb = (bf16_t*)(P.ws() + OFF_SCR + S_YB);
    for (int m = gw; m < MT; m += NGW) {
        float v[32]; float q = 0.f;
#pragma unroll
        for (int c = 0; c < 4; ++c) {
            const u32x4 yv = *(const u32x4*)(yb + (size_t)m * 2048 + lane * 32 + c * 8), zv = *(const u32x4*)(zx + (size_t)m * 6144 + lane * 32 + c * 8);
#pragma unroll
            for (int e = 0; e < 4; ++e) {
                const float y0 = __builtin_bit_cast(float, yv[e] << 16), y1 = __builtin_bit_cast(float, yv[e] & 0xffff0000u);
                const float z0 = __builtin_bit_cast(float, zv[e] << 16), z1 = __builtin_bit_cast(float, zv[e] & 0xffff0000u);
                const float a = y0 * silu_f(z0), b = y1 * silu_f(z1);
                v[c * 8 + 2 * e] = a; v[c * 8 + 2 * e + 1] = b; q += a * a + b * b;
            }
        }
        q = red8(q);
        const float sc = rsqrtf(q * (1.f / 256.f) + 1e-5f);
#pragma unroll
        for (int c = 0; c < 4; ++c) { u32x4 w;
#pragma unroll
            for (int e = 0; e < 4; ++e) w[e] = cvt_pk_bf16(v[c * 8 + 2 * e] * sc, v[c * 8 + 2 * e + 1] * sc);
            *(u32x4*)(yb + (size_t)m * 2048 + lane * 32 + c * 8) = w; }
    }
}

__device__ __forceinline__ void phase_umix(const KA P, int i, int j) {
    int tid_ = threadIdx.x; asm volatile("" : "+v"(tid_)); const int lane = tid_ & 63, gw = blockIdx.x * 8 + (tid_ >> 6), NGW = gridDim.x * 8;
    const bf16_t* h = (const bf16_t*)(P.ws() + OFF_HB); const float* ss = (const float*)(P.ws() + OFF_SS) + (size_t)(4 * i + 1) * MT * 16;
    const float* gn = P.in(11) + (size_t)i * 1024;
    bf16_t* A2 = (bf16_t*)(P.ws() + OFF_SCR + S_A2);
    for (int m = gw; m < MT; m += NGW) {
        const bool pr = m < MP; const int t = pr ? (m & (SEQ - 1)) : ((m - MP) & (LS - 1)); const int b = pr ? (m >> 11) : ((m - MP) >> 2);
        const float s = pg8::rowscale(ss, m); const float sp = t > 0 ? pg8::rowscale(ss, m - 1) : 0.f;
        const bool last = pr ? (t == SEQ - 1) : (t == LS - 1);
        float* sho = pr ? P.out() + O_SHP + (size_t)(j * BP + b) * 1024 : P.out() + O_SHS + (size_t)(j * BS + b) * 1024;
#pragma unroll
        for (int jj = 0; jj < 4; ++jj) { const int c = 4 * lane + 256 * jj;
            const f32x4 gv = *(const f32x4*)(gn + c); const u32x2 hw_ = *(const u32x2*)(h + (size_t)m * 1024 + c);
            f32x4 hv; hv[0] = __builtin_bit_cast(float, hw_.x << 16); hv[1] = __builtin_bit_cast(float, hw_.x & 0xffff0000u); hv[2] = __builtin_bit_cast(float, hw_.y << 16); hv[3] = __builtin_bit_cast(float, hw_.y & 0xffff0000u);
            f32x4 u = hv * gv * s, up;
            if (t > 0) { const u32x2 hq_ = *(const u32x2*)(h + (size_t)(m - 1) * 1024 + c); f32x4 hp; hp[0] = __builtin_bit_cast(float, hq_.x << 16); hp[1] = __builtin_bit_cast(float, hq_.x & 0xffff0000u); hp[2] = __builtin_bit_cast(float, hq_.y << 16); hp[3] = __builtin_bit_cast(float, hq_.y & 0xffff0000u); up = hp * gv * sp; }
            else if (pr) up = (f32x4){0.f, 0.f, 0.f, 0.f};
            else up = *(const f32x4*)(P.in(7) + (size_t)(j * BS + b) * 1024 + c);
            const f32x4 xx = up - u;
            u32x2 w; w.x = cvt_pk_bf16(u[0], u[1]); w.y = cvt_pk_bf16(u[2], u[3]); *(u32x2*)(A2 + (size_t)m * 2048 + c) = w;
            w.x = cvt_pk_bf16(xx[0], xx[1]); w.y = cvt_pk_bf16(xx[2], xx[3]); *(u32x2*)(A2 + (size_t)m * 2048 + 1024 + c) = w;
            if (last) *(f32x4*)(sho + c) = u;
        }
    }
}
__device__ __forceinline__ void wkv_unit(const KA P, int j, int row0, int L, int hd, int half, const float* st0, float* stout, LAS unsigned char* lds) {
    constexpr int T = 32, BUF = 5 * T * 64 + T * 32;
    typedef float f32x2 __attribute__((ext_vector_type(2)));
    int tid_ = threadIdx.x; asm volatile("" : "+v"(tid_)); const int tid = tid_;
    const bool scanner = tid < 256; const int lt = tid & 255;
    LAS float* buf0 = (LAS float*)lds;
    LAS float* ysb = buf0 + 2 * BUF;
    const unsigned char* scr = P.ws() + OFF_SCR;
    const bf16_t* Rb = (const bf16_t*)(scr + S_R); const bf16_t* Kb = Rb + (size_t)MT * 1024;
    const bf16_t* Vb = j == 0 ? (const bf16_t*)(P.ws() + OFF_VF) : (const bf16_t*)(scr + S_V2);
    const bf16_t* VF = (const bf16_t*)(P.ws() + OFF_VF); const bf16_t* Ab = (const bf16_t*)(scr + S_AA); const bf16_t* VG = Ab + (size_t)2 * MT * 1024;
    const float* Db = (const float*)(scr + S_DD);
    bf16_t* yraw = (bf16_t*)(P.ws() + OFF_SCR + S_A2);
    const int nblk = (L + T - 1) / T;
    const int st = lt >> 3, c8 = (lt & 7) * 8, ch = hd * 64 + c8;
    const int il = lt >> 3, jq = lt & 7;
    f32x2 S[4];
    if (scanner) {
        if (st0) { const f32x4 a = __builtin_nontemporal_load((const f32x4*)(st0 + (half * 32 + il) * 64 + jq * 8)), b = __builtin_nontemporal_load((const f32x4*)(st0 + (half * 32 + il) * 64 + jq * 8 + 4));
            S[0] = (f32x2){a[0], a[1]}; S[1] = (f32x2){a[2], a[3]}; S[2] = (f32x2){b[0], b[1]}; S[3] = (f32x2){b[2], b[3]}; }
        else { S[0] = S[1] = S[2] = S[3] = (f32x2){0.f, 0.f}; }
    }
#define WKV_LOAD(blk) do { const int nt_ = (L - (blk) * T) < T ? (L - (blk) * T) : T; \
        const int tt_ = st < nt_ ? st : nt_ - 1; const size_t o_ = (size_t)(row0 + (blk) * T + tt_) * 1024 + ch; \
        _Pragma("unroll") for (int hh = 0; hh < 2; ++hh) { const size_t oo = o_ + 4 * hh; \
            rr_[hh] = ld_bf4(Rb + oo); kr_[hh] = ld_bf4(Kb + oo); dd_[hh] = *(const f32x4*)(Db + oo); aa_[hh] = ld_bf4(Ab + oo); vv_[hh] = ld_bf4(Vb + oo); \
            if (j == 1) { vf_[hh] = ld_bf4(VF + oo); vg_[hh] = ld_bf4(VG + oo); } } } while (0)
#define WKV_FINISH(blk) do { const int nt_ = (L - (blk) * T) < T ? (L - (blk) * T) : T; LAS float* B_ = buf0 + ((blk) & 1) * BUF; \
        f32x4 kk_[2], kp_[2], v2_[2]; \
        _Pragma("unroll") for (int hh = 0; hh < 2; ++hh) { v2_[hh] = vv_[hh]; if (j == 1) v2_[hh] = vv_[hh] + (vf_[hh] - vv_[hh]) * vg_[hh]; \
            kk_[hh] = kr_[hh] * kkw_[hh]; kp_[hh] = kr_[hh] * (1.f + (aa_[hh] - 1.f) * kaw_[hh]); } \
        float q_ = ((kk_[0][0] * kk_[0][0] + kk_[0][1] * kk_[0][1]) + (kk_[0][2] * kk_[0][2] + kk_[0][3] * kk_[0][3])) + ((kk_[1][0] * kk_[1][0] + kk_[1][1] * kk_[1][1]) + (kk_[1][2] * kk_[1][2] + kk_[1][3] * kk_[1][3])); \
        q_ = red8(q_); const float nrm_ = rsqrtf(fmaxf(q_, 1e-24f)); \
        if (st < nt_) { _Pragma("unroll") for (int hh = 0; hh < 2; ++hh) { const f32x4 kn = kk_[hh] * nrm_; \
            *(LAS f32x4*)(B_ + 0 * T * 64 + st * 64 + c8 + 4 * hh) = rr_[hh]; *(LAS f32x4*)(B_ + 1 * T * 64 + st * 64 + c8 + 4 * hh) = dd_[hh]; \
            *(LAS f32x4*)(B_ + 2 * T * 64 + st * 64 + c8 + 4 * hh) = kp_[hh]; *(LAS f32x4*)(B_ + 3 * T * 64 + st * 64 + c8 + 4 * hh) = kn; \
            *(LAS f32x4*)(B_ + 4 * T * 64 + st * 64 + c8 + 4 * hh) = kn * aa_[hh]; \
            if ((c8 >> 5) == half) *(LAS f32x4*)(B_ + 5 * T * 64 + st * 32 + (c8 & 31) + 4 * hh) = v2_[hh]; } } } while (0)
#define WKV_WRITEOUT(blk) do { const int nt_ = (L - (blk) * T) < T ? (L - (blk) * T) : T; const int t_ = lt >> 3, i4_ = (lt & 7) * 4; \
        if (t_ < nt_) { const f32x4 y_ = *(const LAS f32x4*)(ysb + ((blk) & 1) * T * 32 + t_ * 32 + i4_); u32x2 w_; w_.x = cvt_pk_bf16(y_[0], y_[1]); w_.y = cvt_pk_bf16(y_[2], y_[3]); \
            *(u32x2*)(yraw + (size_t)(row0 + (blk) * T + t_) * 1024 + hd * 64 + half * 32 + i4_) = w_; } } while (0)
    f32x4 rr_[2], dd_[2], vv_[2], kr_[2], aa_[2], vf_[2], vg_[2], kkw_[2], kaw_[2];
    if (!scanner) {
#pragma unroll
        for (int hh = 0; hh < 2; ++hh) { kkw_[hh] = *(const f32x4*)(P.in(40) + (size_t)j * 1024 + ch + 4 * hh); kaw_[hh] = *(const f32x4*)(P.in(41) + (size_t)j * 1024 + ch + 4 * hh); }
        WKV_LOAD(0); WKV_FINISH(0); if (1 < nblk) WKV_LOAD(1); }
    __syncthreads();
    for (int blk = 0; blk < nblk; ++blk) {
        if (scanner) {
            const int nt = (L - blk * T) < T ? (L - blk * T) : T; const LAS float* B_ = buf0 + (blk & 1) * BUF; LAS float* Y_ = ysb + (blk & 1) * T * 32;
#define WKV_LDSTEP(X, tt) do { const LAS float* row = B_ + (tt) * 64 + jq * 8; \
                X[0] = *(const LAS f32x4*)(row + 3 * T * 64); X[1] = *(const LAS f32x4*)(row + 3 * T * 64 + 4); X[2] = *(const LAS f32x4*)(row + 1 * T * 64); X[3] = *(const LAS f32x4*)(row + 1 * T * 64 + 4); \
                X[4] = *(const LAS f32x4*)(row + 4 * T * 64); X[5] = *(const LAS f32x4*)(row + 4 * T * 64 + 4); X[6] = *(const LAS f32x4*)(row + 2 * T * 64); X[7] = *(const LAS f32x4*)(row + 2 * T * 64 + 4); \
                X[8] = *(const LAS f32x4*)(row); X[9] = *(const LAS f32x4*)(row + 4); X##v = B_[5 * T * 64 + (tt) * 32 + il]; } while (0)
            f32x4 cu[10], nx[10]; float cuv, nxv = 0.f;
            WKV_LDSTEP(cu, 0);
#pragma unroll 4
            for (int t = 0; t < nt; ++t) {
                if (t + 1 < nt) WKV_LDSTEP(nx, t + 1);
                f32x2 s2 = S[0] * (f32x2){cu[0][0], cu[0][1]} + S[1] * (f32x2){cu[0][2], cu[0][3]} + S[2] * (f32x2){cu[1][0], cu[1][1]} + S[3] * (f32x2){cu[1][2], cu[1][3]};
                const float sa = -red8(s2.x + s2.y);
                const float vi = cuv;
                S[0] = S[0] * (f32x2){cu[2][0], cu[2][1]} + (f32x2){cu[4][0], cu[4][1]} * sa + (f32x2){cu[6][0], cu[6][1]} * vi;
                S[1] = S[1] * (f32x2){cu[2][2], cu[2][3]} + (f32x2){cu[4][2], cu[4][3]} * sa + (f32x2){cu[6][2], cu[6][3]} * vi;
                S[2] = S[2] * (f32x2){cu[3][0], cu[3][1]} + (f32x2){cu[5][0], cu[5][1]} * sa + (f32x2){cu[7][0], cu[7][1]} * vi;
                S[3] = S[3] * (f32x2){cu[3][2], cu[3][3]} + (f32x2){cu[5][2], cu[5][3]} * sa + (f32x2){cu[7][2], cu[7][3]} * vi;
                f32x2 y2 = S[0] * (f32x2){cu[8][0], cu[8][1]} + S[1] * (f32x2){cu[8][2], cu[8][3]} + S[2] * (f32x2){cu[9][0], cu[9][1]} + S[3] * (f32x2){cu[9][2], cu[9][3]};
                const float y = red8(y2.x + y2.y);
                if (jq == 0) Y_[t * 32 + il] = y;
#pragma unroll
                for (int u = 0; u < 10; ++u) cu[u] = nx[u];
                cuv = nxv;
            }
#undef WKV_LDSTEP
        } else {
            if (blk > 0) WKV_WRITEOUT(blk - 1);
            if (blk + 1 < nblk) { WKV_FINISH(blk + 1); if (blk + 2 < nblk) WKV_LOAD(blk + 2); }
        }
        __syncthreads();
    }
    if (!scanner) WKV_WRITEOUT(nblk - 1);
    else { __builtin_nontemporal_store((f32x4){S[0].x, S[0].y, S[1].x, S[1].y}, (f32x4*)(stout + (half * 32 + il) * 64 + jq * 8)); __builtin_nontemporal_store((f32x4){S[2].x, S[2].y, S[3].x, S[3].y}, (f32x4*)(stout + (half * 32 + il) * 64 + jq * 8 + 4)); }
#undef WKV_LOAD
#undef WKV_FINISH
#undef WKV_WRITEOUT
}
__device__ __forceinline__ void phase_wkv(const KA P, int j, LAS unsigned char* lds) {
    for (int u = blockIdx.x; u < 256 + 4096; u += gridDim.x) {
        if (u < 256) { const int b = u >> 5, hd = (u >> 1) & 15, half = u & 1;
            wkv_unit(P, j, b * SEQ, SEQ, hd, half, nullptr, P.out() + O_WKVP + ((size_t)(j * BP + b) * 16 + hd) * 4096, lds);
        } else { const int v = u - 256; const int b = v >> 5, hd = (v >> 1) & 15, half = v & 1;
            wkv_unit(P, j, MP + b * LS, LS, hd, half, P.in(6) + ((size_t)(j * BS + b) * 16 + hd) * 4096, P.out() + O_WKVS + ((size_t)(j * BS + b) * 16 + hd) * 4096, lds);
        }
    }
}
__device__ __forceinline__ void phase_rpost(const KA P, int j) {
    int tid_ = threadIdx.x; asm volatile("" : "+v"(tid_)); const int lane = tid_ & 63, gw = blockIdx.x * 8 + (tid_ >> 6), NGW = gridDim.x * 8;
    const unsigned char* scr = P.ws() + OFF_SCR;
    const bf16_t* Rb = (const bf16_t*)(scr + S_R); const bf16_t* Kb = Rb + (size_t)MT * 1024;
    const bf16_t* Vb = j == 0 ? (const bf16_t*)(P.ws() + OFF_VF) : (const bf16_t*)(scr + S_V2);
    const bf16_t* VF = (const bf16_t*)(P.ws() + OFF_VF); const bf16_t* Ab = (const bf16_t*)(scr + S_AA); const bf16_t* Gb = Ab + (size_t)MT * 1024; const bf16_t* VG = Ab + (size_t)2 * MT * 1024;
    const bf16_t* yraw = (const bf16_t*)(scr + S_A2);
    bf16_t* yb2 = (bf16_t*)(P.ws() + OFF_SCR + S_YB2);
    const int c0 = lane * 16;
    for (int m = gw; m < MT; m += NGW) {
        const size_t o = (size_t)m * 1024 + c0;
        f32x4 y[4], vv[4]; float sum = 0.f, bon = 0.f;
#pragma unroll
        for (int q = 0; q < 4; ++q) {
            y[q] = ld_bf4(yraw + o + 4 * q);
            const f32x4 r4 = ld_bf4(Rb + o + 4 * q), k4 = ld_bf4(Kb + o + 4 * q), a4 = ld_bf4(Ab + o + 4 * q);
            f32x4 v4 = ld_bf4(Vb + o + 4 * q);
            if (j == 1) { const f32x4 vf = ld_bf4(VF + o + 4 * q), vg = ld_bf4(VG + o + 4 * q); v4 = v4 + (vf - v4) * vg; }
            vv[q] = v4;
            const f32x4 kaw = *(const f32x4*)(P.in(41) + (size_t)j * 1024 + c0 + 4 * q), rk = *(const f32x4*)(P.in(42) + (size_t)j * 1024 + c0 + 4 * q);
            const f32x4 kp = k4 * (1.f + (a4 - 1.f) * kaw), t = r4 * kp * rk;
            bon += (t[0] + t[1]) + (t[2] + t[3]);
            sum += (y[q][0] + y[q][1]) + (y[q][2] + y[q][3]);
        }
        sum = red4(sum); bon = red4(bon);
        const float mean = sum * (1.f / 64.f); float var = 0.f;
#pragma unroll
        for (int q = 0; q < 4; ++q) { const f32x4 dlt = y[q] - mean; var += (dlt[0] * dlt[0] + dlt[1] * dlt[1]) + (dlt[2] * dlt[2] + dlt[3] * dlt[3]); }
        var = red4(var) * (1.f / 64.f);
        const float rstd = rsqrtf(var + 64e-5f);
        float o16[16];
#pragma unroll
        for (int q = 0; q < 4; ++q) {
            const f32x4 gw4 = *(const f32x4*)(P.in(43) + (size_t)j * 1024 + c0 + 4 * q), gb4 = *(const f32x4*)(P.in(44) + (size_t)j * 1024 + c0 + 4 * q), g4 = ld_bf4(Gb + o + 4 * q);
            const f32x4 r = ((y[q] - mean) * rstd * gw4 + gb4 + vv[q] * bon) * g4;
            o16[4 * q] = r[0]; o16[4 * q + 1] = r[1]; o16[4 * q + 2] = r[2]; o16[4 * q + 3] = r[3];
        }
        u32x4 w0, w1;
        w0.x = cvt_pk_bf16(o16[0], o16[1]); w0.y = cvt_pk_bf16(o16[2], o16[3]); w0.z = cvt_pk_bf16(o16[4], o16[5]); w0.w = cvt_pk_bf16(o16[6], o16[7]);
        w1.x = cvt_pk_bf16(o16[8], o16[9]); w1.y = cvt_pk_bf16(o16[10], o16[11]); w1.z = cvt_pk_bf16(o16[12], o16[13]); w1.w = cvt_pk_bf16(o16[14], o16[15]);
        *(u32x4*)(yb2 + o) = w0; *(u32x4*)(yb2 + o + 8) = w1;
    }
}
__device__ __forceinline__ void phase_final(const KA P) {
    int tid_ = threadIdx.x; asm volatile("" : "+v"(tid_)); const int lane = tid_ & 63, gw = blockIdx.x * 8 + (tid_ >> 6), NGW = gridDim.x * 8;
    const bf16_t* h = (const bf16_t*)(P.ws() + OFF_SCR + S_HB2); const float* ss = (const float*)(P.ws() + OFF_SS) + (size_t)16 * MT * 16;
    for (int m = gw; m < MT; m += NGW) {
        const float s = pg8::rowscale(ss, m);
#pragma unroll
        for (int jj = 0; jj < 4; ++jj) { const int c = 4 * lane + 256 * jj;
            const u32x2 hw_ = *(const u32x2*)(h + (size_t)m * 1024 + c); f32x4 hv; hv[0] = __builtin_bit_cast(float, hw_.x << 16); hv[1] = __builtin_bit_cast(float, hw_.x & 0xffff0000u); hv[2] = __builtin_bit_cast(float, hw_.y << 16); hv[3] = __builtin_bit_cast(float, hw_.y & 0xffff0000u);
            __builtin_nontemporal_store(hv * s * *(const f32x4*)(P.in(18) + c), (f32x4*)(P.out() + (size_t)m * 1024 + c)); }
    }
}


typedef short bf16x8_t __attribute__((ext_vector_type(8)));
template <int MODE> struct SEpiResid {
    const bf16_t* hin; bf16_t* hout; float* ssn; float alpha; const bf16_t* pe; const float* ssc;
    __device__ __forceinline__ void operator()(int row, int col, f32x4 a, int tr, int tc, int wm, int wn, int fr, int fq, int tid, LAS unsigned char* lds) const {
        const size_t off = (size_t)row * 1024 + col;
        const u32x2 hw = *(const u32x2*)(hin + off);
        f32x4 hv; hv[0] = __builtin_bit_cast(float, hw.x << 16); hv[1] = __builtin_bit_cast(float, hw.x & 0xffff0000u); hv[2] = __builtin_bit_cast(float, hw.y << 16); hv[3] = __builtin_bit_cast(float, hw.y & 0xffff0000u);
        if (MODE == 0) hv = hv + a * alpha;
        else { const float s = pg8::rowscale(ssc, row); const f32x4 pv = ld_bf4(pe + off);
            hv[0] += pv[0] * sigm(s * a[0]); hv[1] += pv[1] * sigm(s * a[1]); hv[2] += pv[2] * sigm(s * a[2]); hv[3] += pv[3] * sigm(s * a[3]); }
        u32x2 w; w.x = cvt_pk_bf16(hv[0], hv[1]); w.y = cvt_pk_bf16(hv[2], hv[3]); *(u32x2*)(hout + off) = w;
        const float r0 = __builtin_bit_cast(float, w.x << 16), r1 = __builtin_bit_cast(float, w.x & 0xffff0000u), r2 = __builtin_bit_cast(float, w.y << 16), r3 = __builtin_bit_cast(float, w.y & 0xffff0000u);
        float q = (r0 * r0 + r1 * r1) + (r2 * r2 + r3 * r3);
        q += __shfl_xor(q, 16); q += __shfl_xor(q, 32);
        LAS float* part = (LAS float*)lds;
        __syncthreads();
        if (fq == 0) part[(wm * 4 + wn) * 16 + fr] = q;
        __syncthreads();
        if (tid < 32) { const int m2 = tid >> 4, f2 = tid & 15;
            const float t = (part[(m2 * 4 + 0) * 16 + f2] + part[(m2 * 4 + 1) * 16 + f2]) + (part[(m2 * 4 + 2) * 16 + f2] + part[(m2 * 4 + 3) * 16 + f2]);
            ssn[(size_t)(MP + tr * 32 + m2 * 16 + f2) * 16 + tc] = t; }
    }
};
struct SEpiPlain { bf16_t* o;
    __device__ __forceinline__ void operator()(int row, int col, f32x4 a, int, int, int, int, int, int, int, LAS unsigned char*) const { u32x2 w; w.x = cvt_pk_bf16(a[0], a[1]); w.y = cvt_pk_bf16(a[2], a[3]); *(u32x2*)(o + (size_t)row * 1024 + col) = w; }
};
template <int K, class SE> __device__ __forceinline__ void small_gemm(const bf16_t* A, const bf16_t* Bt, const SE& E, LAS unsigned char* lds) {
    static_assert(K % 256 == 0, "K/32 k-steps split over 8 waves");
    constexpr int KW = K / 256;
    int tid_ = threadIdx.x; asm volatile("" : "+v"(tid_)); const int tid = tid_, lane = tid & 63, wid = tid >> 6, fr = lane & 15, fq = lane >> 4, wm = wid & 1, wn = wid >> 1;
    LAS f32x4* red = (LAS f32x4*)(lds + 1024);
    for (int tile = blockIdx.x; tile < 256; tile += gridDim.x) {
        const int tr = tile >> 4, tc = tile & 15;
        const bf16_t* ap = A + (size_t)(MP + tr * 32 + fr) * K + wid * (KW * 32) + fq * 8;
        const bf16_t* bp = Bt + (size_t)(tc * 64 + fr) * K + wid * (KW * 32) + fq * 8;
        f32x4 acc[2][4];
#pragma unroll
        for (int a = 0; a < 2; ++a)
#pragma unroll
            for (int b = 0; b < 4; ++b) acc[a][b] = (f32x4){0.f, 0.f, 0.f, 0.f};
        constexpr int BATCH = KW < 4 ? KW : 4;
#pragma unroll
        for (int s0 = 0; s0 < KW; s0 += BATCH) {
            bf16x8_t af[BATCH][2], bf[BATCH][4];
#pragma unroll
            for (int s = 0; s < BATCH; ++s) if (s0 + s < KW) {
#pragma unroll
                for (int a = 0; a < 2; ++a) af[s][a] = *(const bf16x8_t*)(ap + (size_t)(a * 16) * K + (s0 + s) * 32);
#pragma unroll
                for (int b = 0; b < 4; ++b) bf[s][b] = *(const bf16x8_t*)(bp + (size_t)(b * 16) * K + (s0 + s) * 32); }
#pragma unroll
            for (int s = 0; s < BATCH; ++s) if (s0 + s < KW) {
#pragma unroll
                for (int a = 0; a < 2; ++a)
#pragma unroll
                    for (int b = 0; b < 4; ++b) acc[a][b] = __builtin_amdgcn_mfma_f32_16x16x32_bf16(bf[s][b], af[s][a], acc[a][b], 0, 0, 0); }
        }
        __syncthreads();
#pragma unroll
        for (int a = 0; a < 2; ++a)
#pragma unroll
            for (int b = 0; b < 4; ++b) red[(wid * 8 + a + 2 * b) * 64 + lane] = acc[a][b];
        __syncthreads();
        f32x4 tot = red[(0 * 8 + wid) * 64 + lane];
#pragma unroll
        for (int w = 1; w < 8; ++w) tot = tot + red[(w * 8 + wid) * 64 + lane];
        const int row = MP + tr * 32 + wm * 16 + fr;
        E(row, tc * 64 + wn * 16 + 4 * fq, tot, tr, tc, wm, wn, fr, fq, tid, lds);
    }
}

struct PhCtl { int ph, lo, hi; unsigned nbar; };
#ifndef MK_XCDBAR
#define MK_XCDBAR 1
#endif
#define PH_BEGIN if (C.ph >= C.lo && C.ph < C.hi) { const KA P = karg(); int G = gridDim.x, bx = blockIdx.x; asm volatile("" : "+s"(G), "+s"(bx)); (void)G; (void)bx; \
    unsigned char* ws = P.ws(); float* h = (float*)(ws + OFF_H); bf16_t* hb = (bf16_t*)(ws + OFF_HB); float* ss = (float*)(ws + OFF_SS); \
    const bf16_t* WB = (const bf16_t*)(ws + OFF_W); unsigned char* scr = ws + OFF_SCR; (void)h; (void)hb; (void)ss; (void)WB; (void)scr;
#define PH_END   if (C.ph + 1 < C.hi) { if (C.ph == 0) cg::this_grid().sync(); else if (MK_XCDBAR) { XcdBarrier xb_; xb_.bar = (unsigned*)(ws + OFF_CTL) + 64; xb_.x = xb_xcc_id(); xb_.st = (volatile LAS unsigned*)(lds + LDS_BYTES - 64); xcd_barrier(xb_); if (MK_DUP & 8) xcd_barrier(xb_); } else { ++C.nbar; grid_bar((unsigned*)(ws + OFF_CTL), C.nbar * (unsigned)G); if (MK_DUP & 8) { ++C.nbar; grid_bar((unsigned*)(ws + OFF_CTL), C.nbar * (unsigned)G); } } } } ++C.ph;

template <int I, int F> __device__ __forceinline__ void ffn_block(PhCtl& C, LAS unsigned char* lds) {
    constexpr int i = I, f = F;
    PH_BEGIN
    { pg8::Gemm g{(f == 0 && i > 0) ? (const bf16_t*)(scr + S_HB2) : hb, WB + W_FU + (size_t)(4 * f + i) * SZ_FU, MT, 5632, 1024}; pg8::StaticOrder S; S.init(MT, 5632, G, bx);
      pg8::EpiSwiGLU E{ss + (size_t)(4 * i + (f ? 2 : 0)) * MT * 16, (bf16_t*)(scr + S_ACT)};
      pg8::gemm_phase<pg8::EpiSwiGLU, pg8::StaticOrder, true, true>(lds, g, S, E);
      if (MK_DUP & 4) pg8::gemm_phase<pg8::EpiSwiGLU, pg8::StaticOrder, true, true>(lds, g, S, E); }
    if (f == 1) {
      pg8::Gemm g{(const bf16_t*)(ws + OFF_PB) + (size_t)i * MT * 256, WB + W_PI + (size_t)i * SZ_PI, MP, 1024, 256}; pg8::StaticOrder S; S.init(MP, 1024, G, bx);
      pg8::EpiPlain E{(bf16_t*)(scr + S_PE), 1024};
      pg8::gemm_phase<pg8::EpiPlain, pg8::StaticOrder, true, true>(lds, g, S, E);
      SEpiPlain SE{(bf16_t*)(scr + S_PE)};
      small_gemm<256, SEpiPlain>(g.A, g.Bt, SE, lds); }
    PH_END
    PH_BEGIN
    { pg8::Gemm g{(const bf16_t*)(scr + S_ACT), WB + W_FD + (size_t)(4 * f + i) * SZ_FD, MP, 1024, 2816}; pg8::StaticOrder S; S.init(MP, 1024, G, bx);
      pg8::EpiResid<0> E{(f == 0 && i > 0) ? (const bf16_t*)(scr + S_HB2) : (const bf16_t*)hb, hb, ss + (size_t)(4 * i + (f ? 3 : 1)) * MT * 16, 0.5f, nullptr, nullptr};
      pg8::gemm_phase<pg8::EpiResid<0>, pg8::StaticOrder, true, true>(lds, g, S, E);
      SEpiResid<0> SE{E.hin, hb, E.ssn, 0.5f, nullptr, nullptr};
      small_gemm<2816, SEpiResid<0>>(g.A, g.Bt, SE, lds); }
    PH_END
}
template <int I> __device__ __forceinline__ void mixer_block(PhCtl& C, LAS unsigned char* lds) {
    constexpr int i = I, j = I >> 1;
    if constexpr ((I & 1) == 0) {
        PH_BEGIN
        { pg8::Gemm g{hb, WB + W_MI + (size_t)j * SZ_MI, MT, 6400, 1024}; pg8::StaticOrder S; S.init(MT, 6400, G, bx);
          pg8::EpiInProj E{ss + (size_t)(4 * i + 1) * MT * 16, (bf16_t*)(scr + S_ZX), (float*)(scr + S_DTR)};
          pg8::gemm_phase<pg8::EpiInProj, pg8::StaticOrder, true, true>(lds, g, S, E);
          if (MK_DUP & 32) pg8::gemm_phase<pg8::EpiInProj, pg8::StaticOrder, true, true>(lds, g, S, E); }
        PH_END
        PH_BEGIN phase_ssd(P, j, lds); if (MK_DUP & 1) phase_ssd(P, j, lds); PH_END
        PH_BEGIN phase_mgate(P); PH_END
        PH_BEGIN
        { pg8::Gemm g{(const bf16_t*)(scr + S_YB), WB + W_MO + (size_t)j * SZ_MO, MP, 1024, 2048}; pg8::StaticOrder S; S.init(MP, 1024, G, bx);
          pg8::EpiResid<0> E{hb, hb, ss + (size_t)(4 * i + 2) * MT * 16, 1.0f, nullptr, nullptr};
          pg8::gemm_phase<pg8::EpiResid<0>, pg8::StaticOrder, true, true>(lds, g, S, E);
          SEpiResid<0> SE{hb, hb, E.ssn, 1.0f, nullptr, nullptr};
          small_gemm<2048, SEpiResid<0>>(g.A, g.Bt, SE, lds); }
        PH_END
    } else {
        PH_BEGIN phase_umix(P, i, j); if (MK_DUP & 64) phase_umix(P, i, j); PH_END
        PH_BEGIN
        { pg8::Gemm g{(const bf16_t*)(scr + S_A2), WB + W_RK + (size_t)j * SZ_RK, MT, 3584, 2048}; pg8::StaticOrder S; S.init(MT, 3584, G, bx);
          pg8::EpiRkv E{(bf16_t*)(scr + S_R), j == 0 ? (bf16_t*)(ws + OFF_VF) : (bf16_t*)(scr + S_V2), (bf16_t*)(scr + S_HID)};
          pg8::gemm_phase<pg8::EpiRkv, pg8::StaticOrder, true, true>(lds, g, S, E);
          if (MK_DUP & 32) pg8::gemm_phase<pg8::EpiRkv, pg8::StaticOrder, true, true>(lds, g, S, E); }
        PH_END
        PH_BEGIN
        { constexpr int N2 = 4096;
          pg8::Gemm g{(const bf16_t*)(scr + S_HID), WB + W_L2 + (size_t)j * SZ_L2, MT, N2, 384}; pg8::StaticOrder S; S.init(MT, N2, G, bx);
          pg8::EpiLora2 E{(float*)(scr + S_DD), (bf16_t*)(scr + S_AA), P.in(32) + (size_t)j * 1024, P.in(35) + (size_t)j * 1024, P.in(45)};
          pg8::gemm_phase<pg8::EpiLora2, pg8::StaticOrder, true, true>(lds, g, S, E); }
        PH_END
        PH_BEGIN phase_wkv(P, j, lds); if (MK_DUP & 2) phase_wkv(P, j, lds); PH_END
        PH_BEGIN phase_rpost(P, j); if (MK_DUP & 64) phase_rpost(P, j); PH_END
        PH_BEGIN
        { pg8::Gemm g{(const bf16_t*)(scr + S_YB2), WB + W_RO + (size_t)j * SZ_RO, MP, 1024, 1024}; pg8::StaticOrder S; S.init(MP, 1024, G, bx);
          pg8::EpiResid<0> E{hb, hb, ss + (size_t)(4 * i + 2) * MT * 16, 1.0f, nullptr, nullptr};
          pg8::gemm_phase<pg8::EpiResid<0>, pg8::StaticOrder, true, true>(lds, g, S, E);
          SEpiResid<0> SE{hb, hb, E.ssn, 1.0f, nullptr, nullptr};
          small_gemm<1024, SEpiResid<0>>(g.A, g.Bt, SE, lds); }
        PH_END
    }
}
template <int I> __device__ __forceinline__ void layer_block(PhCtl& C, LAS unsigned char* lds) {
    constexpr int i = I;
    ffn_block<I, 0>(C, lds);
    mixer_block<I>(C, lds);
    ffn_block<I, 1>(C, lds);
    PH_BEGIN
    { pg8::Gemm g{hb, WB + W_PG + (size_t)i * SZ_PG, MP, 1024, 1024}; pg8::StaticOrder S; S.init(MP, 1024, G, bx);
      pg8::EpiResid<1> E{hb, (bf16_t*)(scr + S_HB2), ss + (size_t)(4 * i + 4) * MT * 16, 0.f, (const bf16_t*)(scr + S_PE), ss + (size_t)(4 * i + 3) * MT * 16};
      pg8::gemm_phase<pg8::EpiResid<1>, pg8::StaticOrder, true, true>(lds, g, S, E);
      SEpiResid<1> SE{hb, E.hout, E.ssn, 0.f, E.pe, E.ssc};
      small_gemm<1024, SEpiResid<1>>(g.A, g.Bt, SE, lds); }
    PH_END
}
__global__ void __launch_bounds__(512, 2) mk_fwd(Params Pdummy) {
    extern __shared__ __attribute__((aligned(16))) unsigned char lds_raw[];
    LAS unsigned char* lds = (LAS unsigned char*)lds_raw;
    PhCtl C; C.ph = 0; C.nbar = 0;
    if (MK_XCDBAR && !MK_PER_PHASE) { if (threadIdx.x < 16) ((volatile LAS unsigned*)(lds + LDS_BYTES - 64))[threadIdx.x] = 0u; __syncthreads();
        const KA k1 = karg(); (void)xcd_barrier_post((unsigned*)(k1.ws() + OFF_CTL) + 64, (volatile LAS unsigned*)(lds + LDS_BYTES - 64)); }
    { const KA k0 = karg(); C.lo = *(const int __attribute__((address_space(4)))*)(k0.p + 400); C.hi = *(const int __attribute__((address_space(4)))*)(k0.p + 404); }
    PH_BEGIN phase_prologue(P, lds); if (MK_DUP & 16) phase_prologue(P, lds); PH_END
    layer_block<0>(C, lds);
    layer_block<1>(C, lds);
    layer_block<2>(C, lds);
    layer_block<3>(C, lds);
    PH_BEGIN phase_final(P); if (MK_DUP & 64) phase_final(P); PH_END
}
#undef PH_BEGIN
#undef PH_END
constexpr int N_PHASES = 1 + 2 * (4 + 4 + 1) + 2 * (4 + 6 + 1) + 1;

extern "C" void kernel_launch(void* const* d_in, const int* in_sizes, int n_in, void* d_out, int out_size, void* d_ws, size_t ws_size, hipStream_t stream) {
    static int grid = 0;
    if (grid == 0) {
        if (n_in != 48 || (size_t)out_size != O_TOTAL || ws_size < WS_NEED) { fprintf(stderr, "kernel_launch: unexpected shapes n_in %d out %d ws %zu (need %zu)\n", n_in, out_size, ws_size, (size_t)WS_NEED); grid = -1; return; }
        int dev = 0, cus = 0, per_cu = 0;
        hipGetDevice(&dev); hipDeviceGetAttribute(&cus, hipDeviceAttributeMultiprocessorCount, dev);
        if (hipFuncSetAttribute((const void*)mk_fwd, hipFuncAttributeMaxDynamicSharedMemorySize, LDS_BYTES) != hipSuccess) { fprintf(stderr, "kernel_launch: hipFuncSetAttribute failed\n"); grid = -1; return; }
        if (hipOccupancyMaxActiveBlocksPerMultiprocessor(&per_cu, (const void*)mk_fwd, 512, LDS_BYTES) != hipSuccess || per_cu < 1) { fprintf(stderr, "kernel_launch: occupancy query says %d\n", per_cu); per_cu = 1; }
        (void)hipGetLastError();
        grid = cus * 1;
    }
    if (grid < 0) return;
    if (hipMemsetAsync((char*)d_ws + OFF_CTL, 0, 16384, stream) != hipSuccess) { fprintf(stderr, "kernel_launch: memset failed\n"); return; }
    Params p{};
    for (int i = 0; i < 48; ++i) p.in[i] = (const float*)d_in[i];
    p.out = (float*)d_out; p.ws = (unsigned char*)d_ws;
#if MK_PER_PHASE
    for (int k = 0; k < N_PHASES; ++k) { p.ph_lo = k; p.ph_hi = k + 1; hipLaunchKernelGGL(mk_fwd, dim3(grid), dim3(512), LDS_BYTES, stream, p); }
#else
    p.ph_lo = 0; p.ph_hi = N_PHASES;
    void* args[] = {&p};
    hipError_t e = hipLaunchCooperativeKernel((const void*)mk_fwd, dim3(grid), dim3(512), args, LDS_BYTES, stream);
    if (e != hipSuccess) fprintf(stderr, "cooperative launch failed: %s (grid %d)\n", hipGetErrorString(e), grid);
#endif
}
```

```cpp
#include <hip/hip_runtime.h>
#include <hip/hip_cooperative_groups.h>
#include <cstdio>
#include <cstdint>
namespace cg = cooperative_groups;
#define MK_PER_PHASE 0
#define MK_DUP 0
namespace pg8 {
#define PG8_LAS __attribute__((address_space(3)))
typedef unsigned short bf16_t;
typedef short bf16x8 __attribute__((ext_vector_type(8)));
typedef float f32x4 __attribute__((ext_vector_type(4)));
typedef unsigned u32x4 __attribute__((ext_vector_type(4)));
constexpr int BM = 256, BK = 64, HALF = 128, HTB = HALF * BK * 2  , STAGE_BYTES = 8 * HTB, NXCD = 8, WGM = 8;

__host__ __device__ __forceinline__ int lds_byte(int r, int c) { const int st = (r >> 4) * 2 + (c >> 5), rr = r & 15, cc = c & 31, ob = rr * 64 + cc * 2; return st * 1024 + (ob ^ (((ob >> 9) & 1) << 5)); }
__host__ __device__ __forceinline__ void stage_rc(int b, int& R, int& C) { const int st = b / 1024, sb = b % 1024, swz = sb ^ (((sb >> 9) & 1) << 5); R = (st >> 1) * 16 + swz / 64; C = (st & 1) * 32 + (swz % 64) / 2; }
__host__ __device__ __forceinline__ int perm32(int rho) { const int n = rho >> 4, i = rho & 15; return 8 * (i >> 2) + 4 * n + (i & 3); }

struct Unit { int pm, pn; };
struct Gemm { const bf16_t* A; const bf16_t* Bt; int M, N, K; };

struct StaticOrder {
    int nM, nN, nwg, G, c;
    __host__ __device__ void init(int M, int N, int G_, int c_) { nM = M / BM; nN = N / BM; nwg = nM * nN; G = G_; c = c_; }
    __host__ __device__ bool next(int i, Unit& u) const {
        const long L = (long)i * G + c; if (L >= nwg) return false;
        int wgid = (int)L; { const int q = nwg / NXCD, r = nwg % NXCD, xcd = wgid % NXCD, off = wgid / NXCD; wgid = (xcd < r ? xcd * (q + 1) : r * (q + 1) + (xcd - r) * q) + off; }
        const int nig = WGM * nN, gid = wgid / nig, fm = gid * WGM, gsz = (nM - fm) < WGM ? (nM - fm) : WGM;
        u.pm = fm + ((wgid % nig) % gsz); u.pn = (wgid % nig) / gsz; return true;
    }
    __device__ __forceinline__ void a_ready(const Unit&) const {}
    __device__ __forceinline__ void done(const Unit&) const {}
};

typedef float f32x2 __attribute__((ext_vector_type(2)));
typedef __bf16 bf16x2_cv __attribute__((ext_vector_type(2)));
__device__ __forceinline__ unsigned cvt_pk_bf16(float lo, float hi) { const f32x2 v = {lo, hi}; const bf16x2_cv b = __builtin_convertvector(v, bf16x2_cv); return __builtin_bit_cast(unsigned, b); }
typedef unsigned u32x2 __attribute__((ext_vector_type(2)));
__device__ __forceinline__ float sigm(float x) { return __builtin_amdgcn_rcpf(1.f + __expf(-x)); }
__device__ __forceinline__ float sigm_fast(float x) { return __builtin_amdgcn_rcpf(1.f + __expf(-x)); }
__device__ __forceinline__ float silu_f(float x) { return x * __builtin_amdgcn_rcpf(1.f + __expf(-x)); }
__device__ __forceinline__ float rowscale(const float* ss, int row) {
    const f32x4 a = *(const f32x4*)(ss + (size_t)row * 16), b = *(const f32x4*)(ss + (size_t)row * 16 + 4), c = *(const f32x4*)(ss + (size_t)row * 16 + 8), d = *(const f32x4*)(ss + (size_t)row * 16 + 12);
    const float t = ((a[0] + a[1]) + (a[2] + a[3])) + ((b[0] + b[1]) + (b[2] + b[3])) + ((c[0] + c[1]) + (c[2] + c[3])) + ((d[0] + d[1]) + (d[2] + d[3]));
    return rsqrtf(t * (1.f / 1024.f) + 1e-6f); }

__device__ __forceinline__ void rowscales8(const float* ss, int row0, int fq, float (&sc)[8]) {
    f32x4 v[8];
#pragma unroll
    for (int r = 0; r < 8; ++r) v[r] = *(const f32x4*)(ss + (size_t)(row0 + (r >> 2) * HALF + (r & 3) * 16) * 16 + 4 * fq);
#pragma unroll
    for (int r = 0; r < 8; ++r) { float t = (v[r][0] + v[r][1]) + (v[r][2] + v[r][3]); t += __shfl_xor(t, 16); t += __shfl_xor(t, 32); sc[r] = rsqrtf(t * (1.f / 1024.f) + 1e-6f); }
    asm volatile("" ::: "memory");
}
struct EpiSwiGLU {
    static constexpr bool PERM = true, AFTER_DRAIN = false;
    const float* ss; bf16_t* act;
    __device__ __forceinline__ void operator()(const f32x4 (&acc)[2][2][4][2], const Unit& u, int wr, int wc, int fr, int fq) const {
        const int row0 = u.pm * BM + wr * 64 + fr, ff0 = u.pn * 128 + wc * 32 + 8 * fq;
        float sc[8]; rowscales8(ss, row0, fq, sc);
#pragma unroll
        for (int ai = 0; ai < 2; ++ai)
#pragma unroll
            for (int m = 0; m < 4; ++m) {
                const int row = row0 + ai * HALF + m * 16;
                const float s = sc[ai * 4 + m];
                float o[8];
#pragma unroll
                for (int n = 0; n < 2; ++n)
#pragma unroll
                    for (int e = 0; e < 4; ++e) { const float g = acc[ai][0][m][n][e] * s, up = acc[ai][1][m][n][e] * s; o[4 * n + e] = silu_f(g) * up; }
                u32x4 w; w.x = cvt_pk_bf16(o[0], o[1]); w.y = cvt_pk_bf16(o[2], o[3]); w.z = cvt_pk_bf16(o[4], o[5]); w.w = cvt_pk_bf16(o[6], o[7]);
                *(u32x4*)(act + (size_t)row * 2816 + ff0) = w; asm volatile("" ::: "memory");
            }
    }
};
template <int MODE> struct EpiResid {
    static constexpr bool PERM = false, AFTER_DRAIN = false;
    const bf16_t* hin; bf16_t* hout; float* ssn; float alpha; const bf16_t* pe; const float* ssc;
    __device__ __forceinline__ void operator()(const f32x4 (&acc)[2][2][4][2], const Unit& u, int wr, int wc, int fr, int fq) const {
        const int row0 = u.pm * BM + wr * 64 + fr, col0 = u.pn * BM + wc * 32 + 4 * fq;
        float sc[8]; if (MODE == 1) rowscales8(ssc, row0, fq, sc);
#pragma unroll
        for (int ai = 0; ai < 2; ++ai)
#pragma unroll
            for (int m = 0; m < 4; ++m) {
                const int row = row0 + ai * HALF + m * 16;
                float s = 0.f; if (MODE == 1) s = sc[ai * 4 + m];
                float q = 0.f;
#pragma unroll
                for (int bj = 0; bj < 2; ++bj)
#pragma unroll
                    for (int n = 0; n < 2; ++n) {
                        const size_t off = (size_t)row * 1024 + col0 + bj * HALF + n * 16;
                        const u32x2 hw = *(const u32x2*)(hin + off); const f32x4 a = acc[ai][bj][m][n];
                        f32x4 hv; hv[0] = __builtin_bit_cast(float, hw.x << 16); hv[1] = __builtin_bit_cast(float, hw.x & 0xffff0000u); hv[2] = __builtin_bit_cast(float, hw.y << 16); hv[3] = __builtin_bit_cast(float, hw.y & 0xffff0000u);
                        if (MODE == 0) { hv = hv + a * alpha; }
                        else { const u32x2 pw = *(const u32x2*)(pe + off); f32x4 pv; pv[0] = __builtin_bit_cast(float, pw.x << 16); pv[1] = __builtin_bit_cast(float, pw.x & 0xffff0000u); pv[2] = __builtin_bit_cast(float, pw.y << 16); pv[3] = __builtin_bit_cast(float, pw.y & 0xffff0000u);
#pragma unroll
                            for (int e = 0; e < 4; ++e) hv[e] += pv[e] * sigm(s * a[e]); }
                        u32x2 w; w.x = cvt_pk_bf16(hv[0], hv[1]); w.y = cvt_pk_bf16(hv[2], hv[3]);
                        *(u32x2*)(hout + off) = w;
                        const float r0 = __builtin_bit_cast(float, w.x << 16), r1 = __builtin_bit_cast(float, w.x & 0xffff0000u), r2 = __builtin_bit_cast(float, w.y << 16), r3 = __builtin_bit_cast(float, w.y & 0xffff0000u);
                        q += (r0 * r0 + r1 * r1) + (r2 * r2 + r3 * r3);
                    }
                q += __shfl_xor(q, 16); q += __shfl_xor(q, 32);
                if (fq == 0) ssn[(size_t)row * 16 + u.pn * 4 + wc] = q; asm volatile("" ::: "memory");
            }
    }
};
struct EpiInProj {
    static constexpr bool PERM = true, AFTER_DRAIN = false;
    const float* ss; bf16_t* zx; float* dtraw;
    __device__ __forceinline__ void operator()(const f32x4 (&acc)[2][2][4][2], const Unit& u, int wr, int wc, int fr, int fq) const {
        const int row0 = u.pm * BM + wr * 64 + fr, col0 = u.pn * BM + wc * 32 + 8 * fq;
        float sc[8]; rowscales8(ss, row0, fq, sc);
#pragma unroll
        for (int ai = 0; ai < 2; ++ai)
#pragma unroll
            for (int m = 0; m < 4; ++m) {
                const int row = row0 + ai * HALF + m * 16;
                const float s = sc[ai * 4 + m];
                if (u.pn < 24) {
#pragma unroll
                    for (int bj = 0; bj < 2; ++bj) { const f32x4 v0 = acc[ai][bj][m][0] * s, v1 = acc[ai][bj][m][1] * s;
                        u32x4 w; w.x = cvt_pk_bf16(v0[0], v0[1]); w.y = cvt_pk_bf16(v0[2], v0[3]); w.z = cvt_pk_bf16(v1[0], v1[1]); w.w = cvt_pk_bf16(v1[2], v1[3]);
                        *(u32x4*)(zx + (size_t)row * 6144 + col0 + bj * HALF) = w; }
                } else if (wc == 0) {
                    *(f32x4*)(dtraw + (size_t)row * 32 + 8 * fq) = acc[ai][0][m][0] * s;
                    *(f32x4*)(dtraw + (size_t)row * 32 + 8 * fq + 4) = acc[ai][0][m][1] * s;
                }
                asm volatile("" ::: "memory");
            }
    }
};
struct EpiRkv {
    static constexpr bool PERM = false, AFTER_DRAIN = false;
    bf16_t* rk; bf16_t* v; bf16_t* hid;
    __device__ __forceinline__ void operator()(const f32x4 (&acc)[2][2][4][2], const Unit& u, int wr, int wc, int fr, int fq) const {
        const int row0 = u.pm * BM + wr * 64 + fr;
        if (u.pn < 12) {
            bf16_t* dst = u.pn < 8 ? rk + (size_t)(u.pn >> 2) * ((size_t)16896 * 1024) : v;
            const int col0 = (u.pn & 3) * BM + wc * 32 + 4 * fq;
#pragma unroll
            for (int ai = 0; ai < 2; ++ai)
#pragma unroll
                for (int m = 0; m < 4; ++m) { const int row = row0 + ai * HALF + m * 16;
#pragma unroll
                    for (int bj = 0; bj < 2; ++bj)
#pragma unroll
                        for (int n = 0; n < 2; ++n) { const f32x4 a = acc[ai][bj][m][n]; u32x2 w; w.x = cvt_pk_bf16(a[0], a[1]); w.y = cvt_pk_bf16(a[2], a[3]); *(u32x2*)(dst + (size_t)row * 1024 + col0 + bj * HALF + n * 16) = w; } asm volatile("" ::: "memory"); }
        } else {
            const int col0 = (u.pn - 12) * BM + wc * 32 + 4 * fq;
#pragma unroll
            for (int ai = 0; ai < 2; ++ai)
#pragma unroll
                for (int m = 0; m < 4; ++m) { const int row = row0 + ai * HALF + m * 16;
#pragma unroll
                    for (int bj = 0; bj < 2; ++bj)
#pragma unroll
                        for (int n = 0; n < 2; ++n) { const int lc = col0 + bj * HALF + n * 16;
                            if (lc < 384) { f32x4 a = acc[ai][bj][m][n];
                                if (lc < 64) { a[0] = tanhf(a[0]); a[1] = tanhf(a[1]); a[2] = tanhf(a[2]); a[3] = tanhf(a[3]); }
                                else if (lc >= 128 && lc < 288) { a[0] = sigm(a[0]); a[1] = sigm(a[1]); a[2] = sigm(a[2]); a[3] = sigm(a[3]); }
                                else if (lc >= 320) { a = (f32x4){0.f, 0.f, 0.f, 0.f}; }
                                u32x2 w; w.x = cvt_pk_bf16(a[0], a[1]); w.y = cvt_pk_bf16(a[2], a[3]);
                                *(u32x2*)(hid + (size_t)row * 384 + lc) = w; } } asm volatile("" ::: "memory"); }
        }
    }
};
struct EpiLora2 {
    static constexpr bool PERM = false, AFTER_DRAIN = false;
    float* dd; bf16_t* agv; const float* w0; const float* a0; const float* v0;
    template <int Q> __device__ __forceinline__ void body(const f32x4 (&acc)[2][2][4][2], const float* bias, int row0, int col0) const {
#pragma unroll
        for (int bj = 0; bj < 2; ++bj)
#pragma unroll
            for (int n = 0; n < 2; ++n) { const int col = col0 + bj * HALF + n * 16;
                f32x4 bv = (f32x4){0.f, 0.f, 0.f, 0.f}; if (Q != 2) bv = *(const f32x4*)(bias + col);
#pragma unroll
                for (int ai = 0; ai < 2; ++ai)
#pragma unroll
                    for (int m = 0; m < 4; ++m) { const int row = row0 + ai * HALF + m * 16; f32x4 x = acc[ai][bj][m][n] + bv;
                        if (Q == 0) {
#pragma unroll
                            for (int e = 0; e < 4; ++e) { const float y = -x[e]; const float sp = fmaxf(y, 0.f) + log1pf(__expf(-fabsf(y))); x[e] = __expf(-__expf(-sp - 0.5f)); } }
                        else if (Q != 2) { x[0] = sigm_fast(x[0]); x[1] = sigm_fast(x[1]); x[2] = sigm_fast(x[2]); x[3] = sigm_fast(x[3]); }
                        if (Q == 0) *(f32x4*)(dd + (size_t)row * 1024 + col) = x;
                        else { u32x2 w; w.x = cvt_pk_bf16(x[0], x[1]); w.y = cvt_pk_bf16(x[2], x[3]); *(u32x2*)(agv + (size_t)(Q - 1) * ((size_t)16896 * 1024) + (size_t)row * 1024 + col) = w; }
                        asm volatile("" ::: "memory"); } }
    }
    __device__ __forceinline__ void operator()(const f32x4 (&acc)[2][2][4][2], const Unit& u, int wr, int wc, int fr, int fq) const {
        const int row0 = u.pm * BM + wr * 64 + fr, q = u.pn >> 2, col0 = (u.pn & 3) * BM + wc * 32 + 4 * fq;
        if (q == 0) body<0>(acc, w0, row0, col0);
        else if (q == 1) body<1>(acc, a0, row0, col0);
        else if (q == 2) body<2>(acc, nullptr, row0, col0);
        else body<3>(acc, v0, row0, col0);
    }
};
struct EpiPlain {
    static constexpr bool PERM = false, AFTER_DRAIN = false;
    bf16_t* o; int ldc;
    __device__ __forceinline__ void operator()(const f32x4 (&acc)[2][2][4][2], const Unit& u, int wr, int wc, int fr, int fq) const {
        const int row0 = u.pm * BM + wr * 64 + fr, col0 = u.pn * BM + wc * 32 + 4 * fq;
#pragma unroll
        for (int ai = 0; ai < 2; ++ai)
#pragma unroll
            for (int m = 0; m < 4; ++m) { const int row = row0 + ai * HALF + m * 16;
#pragma unroll
                for (int bj = 0; bj < 2; ++bj)
#pragma unroll
                    for (int n = 0; n < 2; ++n) { const f32x4 a = acc[ai][bj][m][n]; u32x2 w; w.x = cvt_pk_bf16(a[0], a[1]); w.y = cvt_pk_bf16(a[2], a[3]); *(u32x2*)(o + (size_t)row * ldc + col0 + bj * HALF + n * 16) = w; }
                asm volatile("" ::: "memory"); }
    }
};
template <class Epi, class Sched, bool ALIGN_EPI = false, bool SP2 = false>
__device__ __forceinline__ void gemm_phase(PG8_LAS unsigned char* lds, const Gemm g, const Sched& S, const Epi& E) {
    int tid_ = threadIdx.x; asm volatile("" : "+v"(tid_)); const int tid = tid_, wid = __builtin_amdgcn_readfirstlane(tid >> 6), lane = tid & 63, wr = wid >> 2, wc = wid & 3, fr = lane & 15, fq = lane >> 4;
    const int K = g.K, nt = K / BK;
    unsigned voffA[2], voffB[2];
#pragma unroll
    for (int i = 0; i < 2; ++i) { int R, C; stage_rc(tid * 16 + i * 8192, R, C); const int Rb = Epi::PERM ? ((R & ~31) + perm32(R & 31)) : R;
        voffA[i] = (unsigned)(R * K + C) * 2u; voffB[i] = (unsigned)(Rb * K + C) * 2u; }
    const size_t kstep = (size_t)(BK * 2);
    const size_t hstep = (size_t)HALF * K * 2;
    const size_t tstep = 2 * hstep;
    const unsigned ldsw = (unsigned)wid * 1024u;
    const int aoff = lds_byte(wr * 64 + fr, fq * 8), boff = lds_byte(wc * 32 + fr, fq * 8);
#define PG8_SA(b, h) (((b) * 2 + (h)) * HTB)
#define PG8_SB(b, h) ((4 + (b) * 2 + (h)) * HTB)
#define PG8_STAGE(bufoff, gbase, voff) do { _Pragma("unroll") for (int _i = 0; _i < 2; ++_i) \
        __builtin_amdgcn_global_load_lds((const unsigned*)((const char*)(gbase) + (voff)[_i]), (PG8_LAS unsigned*)(lds + (bufoff) + ldsw + _i * 8192), 16, 0, 0); } while (0)
#define PG8_LDA(dst, b, h) do { _Pragma("unroll") for (int m = 0; m < 4; ++m) _Pragma("unroll") for (int k = 0; k < 2; ++k) dst[m][k] = *(const PG8_LAS bf16x8*)(lds + PG8_SA(b, h) + aoff + m * 2048 + k * 1024); } while (0)
#define PG8_LDB(dst, b, h) do { _Pragma("unroll") for (int n = 0; n < 2; ++n) _Pragma("unroll") for (int k = 0; k < 2; ++k) dst[n][k] = *(const PG8_LAS bf16x8*)(lds + PG8_SB(b, h) + boff + n * 2048 + k * 1024); } while (0)
#define PG8_MMA(ai, bj, At, Bt) do { __builtin_amdgcn_s_setprio(1); _Pragma("unroll") for (int m = 0; m < 4; ++m) _Pragma("unroll") for (int n = 0; n < 2; ++n) _Pragma("unroll") for (int k = 0; k < 2; ++k) \
        acc[ai][bj][m][n] = __builtin_amdgcn_mfma_f32_16x16x32_bf16(Bt[n][k], At[m][k], acc[ai][bj][m][n], 0, 0, 0); __builtin_amdgcn_s_setprio(0); } while (0)
#define PG8_WAIT_V(n) asm volatile("s_waitcnt vmcnt(" #n ")" ::: "memory")
#define PG8_WAIT_L(n) asm volatile("s_waitcnt lgkmcnt(" #n ")" ::: "memory")
#define PG8_BAR __builtin_amdgcn_s_barrier()
#define PG8_SCHED __builtin_amdgcn_sched_barrier(0)
    Unit cur, nxt; int ui = 0;
    if (!S.next(0, cur)) return;
    f32x4 acc[2][2][4][2];
#pragma unroll
    for (int a = 0; a < 2; ++a)
#pragma unroll
        for (int b = 0; b < 2; ++b)
#pragma unroll
            for (int m = 0; m < 4; ++m)
#pragma unroll
                for (int n = 0; n < 2; ++n) acc[a][b][m][n] = (f32x4){0.f, 0.f, 0.f, 0.f};
    bf16x8 At[4][2], B0[2][2], B1[2][2];
    const char* cA = (const char*)g.A + (size_t)cur.pm * tstep; const char* cB = (const char*)g.Bt + (size_t)cur.pn * tstep;
    S.a_ready(cur);
    if constexpr (SP2) {
        PG8_STAGE(PG8_SB(0, 0), cB, voffB); PG8_STAGE(PG8_SB(0, 1), cB + hstep, voffB); PG8_STAGE(PG8_SA(0, 0), cA, voffA); PG8_STAGE(PG8_SA(0, 1), cA + hstep, voffA);
        if (wr == 1) PG8_BAR;
        PG8_WAIT_V(2); PG8_BAR;
        PG8_STAGE(PG8_SB(1, 0), cB + kstep, voffB); PG8_STAGE(PG8_SA(1, 0), cA + kstep, voffA); PG8_STAGE(PG8_SB(1, 1), cB + hstep + kstep, voffB);
        PG8_WAIT_V(6); PG8_BAR;
    } else {
        PG8_STAGE(PG8_SB(0, 0), cB, voffB); PG8_STAGE(PG8_SA(0, 0), cA, voffA); PG8_STAGE(PG8_SB(0, 1), cB + hstep, voffB); PG8_STAGE(PG8_SA(0, 1), cA + hstep, voffA);
        if (wr == 1) PG8_BAR;
        PG8_WAIT_V(4); PG8_BAR;
        PG8_STAGE(PG8_SB(1, 0), cB + kstep, voffB); PG8_STAGE(PG8_SA(1, 0), cA + kstep, voffA); PG8_STAGE(PG8_SB(1, 1), cB + hstep + kstep, voffB);
        PG8_WAIT_V(6); PG8_BAR;
    }
    for (;;) {
        const bool has_next = S.next(ui + 1, nxt);
        const char* nA = has_next ? (const char*)g.A + (size_t)nxt.pm * tstep : cA; const char* nB = has_next ? (const char*)g.Bt + (size_t)nxt.pn * tstep : cB;
#pragma unroll 1
        for (int t = 0; t < nt; t += 2) {
            const bool last = (t == nt - 2);
            const char* a1 = cA + (size_t)(t + 1) * kstep;
            const char* a2 = last ? nA : cA + (size_t)(t + 2) * kstep; const char* b2 = last ? nB : cB + (size_t)(t + 2) * kstep;
            const char* a3 = a2 + kstep; const char* b3 = b2 + kstep;
            if (last && has_next) S.a_ready(nxt);
            if constexpr (SP2) {
            PG8_LDB(B0, 0, 0); PG8_LDB(B1, 0, 1); PG8_SCHED; PG8_LDA(At, 0, 0); PG8_STAGE(PG8_SA(1, 1), a1 + hstep, voffA);
            PG8_WAIT_V(8); PG8_WAIT_L(0); PG8_BAR; PG8_MMA(0, 0, At, B0); PG8_MMA(0, 1, At, B1); PG8_BAR; PG8_SCHED;
            PG8_LDA(At, 0, 1); PG8_STAGE(PG8_SB(0, 0), b2, voffB); PG8_STAGE(PG8_SB(0, 1), b2 + hstep, voffB); PG8_STAGE(PG8_SA(0, 0), a2, voffA);
            PG8_WAIT_V(8); PG8_WAIT_L(0); PG8_BAR; PG8_MMA(1, 0, At, B0); PG8_MMA(1, 1, At, B1); PG8_BAR; PG8_SCHED;
            PG8_LDB(B0, 1, 0); PG8_LDB(B1, 1, 1); PG8_SCHED; PG8_LDA(At, 1, 0); PG8_STAGE(PG8_SA(0, 1), a2 + hstep, voffA);
            PG8_WAIT_V(8); PG8_WAIT_L(0); PG8_BAR; PG8_MMA(0, 0, At, B0); PG8_MMA(0, 1, At, B1); PG8_BAR; PG8_SCHED;
            PG8_LDA(At, 1, 1); PG8_STAGE(PG8_SB(1, 0), b3, voffB); PG8_STAGE(PG8_SB(1, 1), b3 + hstep, voffB); PG8_STAGE(PG8_SA(1, 0), a3, voffA);
            PG8_WAIT_V(8); PG8_WAIT_L(0); PG8_BAR; PG8_MMA(1, 0, At, B0); PG8_MMA(1, 1, At, B1); PG8_BAR; PG8_SCHED;
            } else {
            PG8_LDB(B0, 0, 0); PG8_SCHED; PG8_LDA(At, 0, 0); PG8_STAGE(PG8_SA(1, 1), a1 + hstep, voffA);
            PG8_WAIT_L(8); PG8_BAR; PG8_WAIT_L(0); PG8_MMA(0, 0, At, B0); PG8_BAR; PG8_SCHED;
            PG8_LDB(B1, 0, 1); PG8_STAGE(PG8_SB(0, 0), b2, voffB);
            PG8_BAR; PG8_WAIT_L(0); PG8_MMA(0, 1, At, B1); PG8_BAR;
            PG8_LDA(At, 0, 1); PG8_STAGE(PG8_SA(0, 0), a2, voffA);
            PG8_BAR; PG8_WAIT_L(0); PG8_MMA(1, 0, At, B0); PG8_BAR; PG8_SCHED;
            PG8_STAGE(PG8_SB(0, 1), b2 + hstep, voffB);
            PG8_WAIT_V(6); PG8_BAR; PG8_MMA(1, 1, At, B1); PG8_BAR;
            PG8_LDB(B0, 1, 0); PG8_SCHED; PG8_LDA(At, 1, 0); PG8_STAGE(PG8_SA(0, 1), a2 + hstep, voffA);
            PG8_WAIT_L(8); PG8_BAR; PG8_WAIT_L(0); PG8_MMA(0, 0, At, B0); PG8_BAR; PG8_SCHED;
            PG8_LDB(B1, 1, 1); PG8_STAGE(PG8_SB(1, 0), b3, voffB);
            PG8_BAR; PG8_WAIT_L(0); PG8_MMA(0, 1, At, B1); PG8_BAR;
            PG8_LDA(At, 1, 1); PG8_STAGE(PG8_SA(1, 0), a3, voffA);
            PG8_BAR; PG8_WAIT_L(0); PG8_MMA(1, 0, At, B0); PG8_BAR; PG8_SCHED;
            PG8_STAGE(PG8_SB(1, 1), b3 + hstep, voffB);
            PG8_WAIT_V(6); PG8_BAR; PG8_MMA(1, 1, At, B1); PG8_BAR;
            }
        }
        if constexpr (ALIGN_EPI) { if (wr == 0) PG8_BAR; }
        if constexpr (!Epi::AFTER_DRAIN) { E(acc, cur, wr, wc, fr, fq); S.done(cur); }
        if (!has_next) break;
#pragma unroll
        for (int a = 0; a < 2; ++a)
#pragma unroll
            for (int b = 0; b < 2; ++b)
#pragma unroll
                for (int m = 0; m < 4; ++m)
#pragma unroll
                    for (int n = 0; n < 2; ++n) acc[a][b][m][n] = (f32x4){0.f, 0.f, 0.f, 0.f};
        cur = nxt; cA = nA; cB = nB; ++ui;
        if constexpr (ALIGN_EPI) { if (wr == 1) PG8_BAR; }
    }
    PG8_WAIT_V(0);
    if constexpr (!ALIGN_EPI) { if (wr == 0) PG8_BAR; }
    PG8_BAR;
    if constexpr (Epi::AFTER_DRAIN) { E.fused(acc, cur, wr, wc, fr, fq, lds, wid, lane); S.done(cur); }
#undef PG8_SA
#undef PG8_SB
#undef PG8_STAGE
#undef PG8_LDA
#undef PG8_LDB
#undef PG8_MMA
#undef PG8_WAIT_V
#undef PG8_WAIT_L
#undef PG8_BAR
#undef PG8_SCHED
}
}
#define LAS __attribute__((address_space(3)))
typedef pg8::bf16_t bf16_t;
typedef pg8::f32x4 f32x4;
typedef pg8::u32x4 u32x4;
typedef pg8::u32x2 u32x2;
using pg8::cvt_pk_bf16; using pg8::sigm; using pg8::silu_f;

#ifndef MK_DUP
#define MK_DUP 0
#endif
#ifndef MK_PER_PHASE
#define MK_PER_PHASE 0
#endif
constexpr int D = 1024, MT = 16896, MP = 16384, FFD = 2816;
constexpr int SEQ = 2048, BP = 8, BS = 128, LS = 4;
constexpr int LDS_BYTES = 147456;
constexpr size_t O_YP = 0, O_YS = 16777216, O_SSMP = 17301504, O_CONVP = 21495808, O_WKVP = 21692416, O_SHP = 22740992,
                 O_SSMS = 22757376, O_CONVS = 89866240, O_WKVS = 93011968, O_SHS = 109789184, O_TOTAL = 110051328;
constexpr size_t OFF_CTL = 0, OFF_H = 16384, OFF_HB = OFF_H + (size_t)MT * 1024 * 4, OFF_SS = OFF_HB + (size_t)MT * 1024 * 2, OFF_PB = OFF_SS + (size_t)17 * MT * 16 * 4,
                 OFF_VF = OFF_PB + (size_t)4 * MT * 256 * 2, OFF_W = OFF_VF + (size_t)MT * 1024 * 4;
constexpr size_t W_FU = 0, SZ_FU = (size_t)5632 * 1024;
constexpr size_t W_FD = W_FU + 8 * SZ_FU, SZ_FD = (size_t)1024 * 2816;
constexpr size_t W_PI = W_FD + 8 * SZ_FD, SZ_PI = (size_t)1024 * 256;
constexpr size_t W_PG = W_PI + 4 * SZ_PI, SZ_PG = (size_t)1024 * 1024;
constexpr size_t W_MI = W_PG + 4 * SZ_PG, SZ_MI = (size_t)6400 * 1024;
constexpr size_t W_MO = W_MI + 2 * SZ_MI, SZ_MO = (size_t)1024 * 2048;
constexpr size_t W_RK = W_MO + 2 * SZ_MO, SZ_RK = (size_t)3584 * 2048;
constexpr size_t W_RO = W_RK + 2 * SZ_RK, SZ_RO = (size_t)1024 * 1024;
constexpr size_t W_L2 = W_RO + 2 * SZ_RO, SZ_L2 = (size_t)4096 * 384;
constexpr size_t W_TOTAL = W_L2 + 2 * SZ_L2;
constexpr size_t OFF_SCR = OFF_W + W_TOTAL * 2;
constexpr size_t S_ACT = 0, S_PE = (size_t)MT * 2816 * 2, S_HB2 = S_PE + (size_t)MT * 1024 * 4;
constexpr size_t S_ZX = 0, S_DTR = (size_t)MT * 6144 * 2, S_YB = S_DTR + (size_t)MT * 32 * 4;
constexpr size_t SZF = (size_t)MT * 1024 * 4;
constexpr size_t S_A2 = 0, S_R = SZF, S_K = 2 * SZF, S_V2 = 3 * SZF, S_DD = 4 * SZF, S_AA = 5 * SZF, S_GG = 6 * SZF, S_VG = 7 * SZF, S_HID = 8 * SZF,
                 S_YB2 = S_HID + (size_t)MT * 384 * 2, S_END = S_YB2 + (size_t)MT * 1024 * 2;
constexpr size_t WS_NEED = OFF_SCR + S_END;

struct Params { const float* in[48]; float* out; unsigned char* ws; int ph_lo, ph_hi; };
typedef const unsigned char __attribute__((address_space(4)))* kptr_t;
struct KA {
    kptr_t p;
    __device__ __forceinline__ const float* in(int k) const { return *(const float* const __attribute__((address_space(4)))*)(p + 8 * k); }
    __device__ __forceinline__ float* out() const { return *(float* const __attribute__((address_space(4)))*)(p + 384); }
    __device__ __forceinline__ unsigned char* ws() const { return *(unsigned char* const __attribute__((address_space(4)))*)(p + 392); }
};
__device__ __forceinline__ KA karg() { KA k; k.p = (kptr_t)__builtin_amdgcn_kernarg_segment_ptr(); asm volatile("" : "+s"(k.p)); return k; }
static_assert(sizeof(Params) == 408, "kernarg layout");

#define LDS_WAIT() asm volatile("s_waitcnt lgkmcnt(0)" ::: "memory")
__device__ __forceinline__ float bf2f(bf16_t b) { return __builtin_bit_cast(float, (unsigned)b << 16); }
__device__ __forceinline__ f32x4 ld_bf4(const bf16_t* p) { const u32x2 w = *(const u32x2*)p; f32x4 r; r[0] = __builtin_bit_cast(float, w.x << 16); r[1] = __builtin_bit_cast(float, w.x & 0xffff0000u); r[2] = __builtin_bit_cast(float, w.y << 16); r[3] = __builtin_bit_cast(float, w.y & 0xffff0000u); return r; }
template <int CTRL> __device__ __forceinline__ float dppf(float x) { return __builtin_bit_cast(float, __builtin_amdgcn_update_dpp(0, __builtin_bit_cast(int, x), CTRL, 0xf, 0xf, true)); }
__device__ __forceinline__ float red4(float v) { v += dppf<0xB1>(v); v += dppf<0x4E>(v); return v; }
__device__ __forceinline__ float red8(float v) { v = red4(v); v += dppf<0x141>(v); return v; }
__device__ __forceinline__ float red16(float v) { v = red8(v); v += dppf<0x140>(v); return v; }
__device__ __forceinline__ float wave_sum(float v) {
#pragma unroll
    for (int o = 1; o < 64; o <<= 1) v += __shfl_xor(v, o);
    return v;
}
__device__ __forceinline__ float softplus_f(float y) { return fmaxf(y, 0.f) + log1pf(__expf(-fabsf(y))); }

#define XB_TMO      128
#define XB_XCNT(j)  (256  + 64 * (j))
#define XB_XSUB(j)  (1280 + 64 * (j))
#define XB_XGEN(j)  (2304 + 64 * (j))
#define XB_TOP      3328
#define XB_TOPGEN   3392
#define XCD_BAR_WORDS 3456
#define XB_SPIN_CAP (1u << 18)

__device__ __forceinline__ unsigned xb_ld(unsigned* p)              { return __hip_atomic_load(p, __ATOMIC_RELAXED, __HIP_MEMORY_SCOPE_AGENT); }
__device__ __forceinline__ unsigned xb_add(unsigned* p, unsigned v) { return __hip_atomic_fetch_add(p, v, __ATOMIC_RELAXED, __HIP_MEMORY_SCOPE_AGENT); }
__device__ __forceinline__ unsigned xb_xcc_id() { return (unsigned)__builtin_amdgcn_s_getreg((3 << 11) | 20) & 0xFu; }
#define XB_SPIN(cond, bar) do { unsigned _sp = 0; while (cond) { __builtin_amdgcn_s_sleep(1); \
    if ((++_sp & 255u) == 0u) { if (xb_ld(&(bar)[XB_TMO])) break; if (_sp > XB_SPIN_CAP) { atomicAdd(&(bar)[XB_TMO], 1u); break; } } } } while (0)

struct XcdBarrier {
    unsigned* bar; unsigned x;
    volatile LAS unsigned* st;
};

__device__ __forceinline__ XcdBarrier xcd_barrier_post(unsigned* bar, volatile LAS unsigned* st) {
    XcdBarrier b; b.bar = bar; b.x = xb_xcc_id(); b.st = st;
    if (threadIdx.x == 0) (void)xb_add(&bar[XB_XCNT(b.x)], 1u);
    return b;
}
__device__ __forceinline__ void xcd_barrier_complete(unsigned* bar, unsigned x, unsigned& nloc, unsigned& nx) {
    const unsigned G = gridDim.x * gridDim.y * gridDim.z;
    unsigned sum, cnt, mine, sp = 0u;
    for (;;) {
        sum = 0u; cnt = 0u; mine = 0u;
#pragma unroll
        for (unsigned j = 0; j < 16; ++j) { const unsigned c = xb_ld(&bar[XB_XCNT(j)]); sum += c; cnt += (c > 0u) ? 1u : 0u; mine = (j == x) ? c : mine; }
        if (sum == G) break;
        __builtin_amdgcn_s_sleep(1);
        if ((++sp & 255u) == 0u) { if (xb_ld(&bar[XB_TMO])) break; if (sp > XB_SPIN_CAP) { atomicAdd(&bar[XB_TMO], 1u); break; } }
    }
    nloc = mine > 0u ? mine : 1u; nx = cnt > 0u ? cnt : 1u;
}

__device__ __forceinline__ void xcd_barrier(const XcdBarrier& b) {
    asm volatile("s_waitcnt vmcnt(0)" ::: "memory");
    __syncthreads();
    if (threadIdx.x == 0) {
        unsigned* bar = b.bar;
        __builtin_amdgcn_s_waitcnt(0);
        unsigned nloc = b.st[0], nx = b.st[1];
        if (nloc == 0u) { xcd_barrier_complete(bar, b.x, nloc, nx); b.st[0] = nloc; b.st[1] = nx; }
        const unsigned old = xb_add(&bar[XB_XSUB(b.x)], 1u);
        const unsigned gen = old / nloc;
        if (old + 1u == (gen + 1u) * nloc) {
            __builtin_amdgcn_fence(__ATOMIC_RELEASE, "agent");
            asm volatile("s_waitcnt vmcnt(0)" ::: "memory");
            const unsigned og = xb_add(&bar[XB_TOP], 1u);
            const unsigned tg = og / nx;
            if (og + 1u == (tg + 1u) * nx) xb_add(&bar[XB_TOPGEN], 1u);
            else XB_SPIN(xb_ld(&bar[XB_TOPGEN]) == tg, bar);
            __builtin_amdgcn_fence(__ATOMIC_ACQUIRE, "agent");
            xb_add(&bar[XB_XGEN(b.x)], 1u);
            asm volatile("s_waitcnt vmcnt(0)" ::: "memory");
        } else {
            XB_SPIN(xb_ld(&bar[XB_XGEN(b.x)]) == gen, bar);
            __builtin_amdgcn_fence(__ATOMIC_ACQUIRE, "agent");
            asm volatile("s_waitcnt vmcnt(0)" ::: "memory");
        }
    }
    __syncthreads();
}

__device__ __forceinline__ void grid_bar(unsigned* cnt, unsigned target) {
    asm volatile("s_waitcnt vmcnt(0) lgkmcnt(0)" ::: "memory");
    __syncthreads();
    if (threadIdx.x == 0) {
        __builtin_amdgcn_fence(__ATOMIC_RELEASE, "agent");
        asm volatile("s_waitcnt vmcnt(0)" ::: "memory");
        __hip_atomic_fetch_add(cnt, 1u, __ATOMIC_RELAXED, __HIP_MEMORY_SCOPE_AGENT);
        while (__hip_atomic_load(cnt, __ATOMIC_RELAXED, __HIP_MEMORY_SCOPE_AGENT) < target) __builtin_amdgcn_s_sleep(2);
        __builtin_amdgcn_fence(__ATOMIC_ACQUIRE, "agent");
        asm volatile("s_waitcnt vmcnt(0)" ::: "memory");
    }
    __syncthreads();
}
__device__ __forceinline__ void tr_matrix(const float* __restrict__ W, int Ks, int Ns, bf16_t* dst, int ldd, int drow0, int dcol0, const float* __restrict__ kscale, int mode,
                                          int& base, int gw, int NGW, LAS float* scr, int lane) {
    const int nblk = Ns >> 5, nitems = (Ks >> 6) * nblk;
    const int first = (gw - (base % NGW) + NGW) % NGW;
    for (int it = first; it < nitems; it += NGW) {
        const int kb = it / nblk, nb = it - kb * nblk, k0 = kb * 64, n0 = nb * 32;
        float vv[32];
#pragma unroll
        for (int i = 0; i < 32; ++i) { const int kk = 2 * i + (lane >> 5); vv[i] = __builtin_nontemporal_load(W + (size_t)(k0 + kk) * Ns + n0 + (lane & 31)); }
        if (kscale) {
#pragma unroll
            for (int i = 0; i < 32; ++i) vv[i] *= kscale[k0 + 2 * i + (lane >> 5)]; }
#pragma unroll
        for (int i = 0; i < 32; ++i) scr[(2 * i + (lane >> 5)) * 33 + (lane & 31)] = vv[i];
        LDS_WAIT();
        int dr = n0;
        if (mode == 1) dr = n0 < 2816 ? (n0 / 128) * 256 + (n0 % 128) : ((n0 - 2816) / 128) * 256 + 128 + ((n0 - 2816) % 128);
        dr += drow0;
        const int c = lane & 7;
#pragma unroll
        for (int j = 0; j < 4; ++j) { const int n = (lane >> 3) + 8 * j; const LAS float* s = scr + (8 * c) * 33 + n;
            u32x4 o; o.x = cvt_pk_bf16(s[0 * 33], s[1 * 33]); o.y = cvt_pk_bf16(s[2 * 33], s[3 * 33]); o.z = cvt_pk_bf16(s[4 * 33], s[5 * 33]); o.w = cvt_pk_bf16(s[6 * 33], s[7 * 33]);
            *(u32x4*)(dst + (size_t)(dr + n) * ldd + dcol0 + k0 + 8 * c) = o; }
        LDS_WAIT();
    }
    base += nitems;
}

__device__ __forceinline__ void phase_prologue(const KA P, LAS unsigned char* lds) {
    int tid_ = threadIdx.x; asm volatile("" : "+v"(tid_)); const int tid = tid_, lane = tid & 63, wave = tid >> 6;
    const int gw = blockIdx.x * 8 + wave, NGW = gridDim.x * 8;
    LAS float* scr = (LAS float*)(lds + wave * 16384);
    bf16_t* WB = (bf16_t*)(P.ws() + OFF_W);
    int base = 0;
    for (int i = 0; i < 4; ++i) {
        tr_matrix(P.in(9) + (size_t)i * 1024 * 5632, 1024, 5632, WB + W_FU + (size_t)i * SZ_FU, 1024, 0, 0, P.in(8) + i * 1024, 1, base, gw, NGW, scr, lane);
        tr_matrix(P.in(13) + (size_t)i * 1024 * 5632, 1024, 5632, WB + W_FU + (size_t)(4 + i) * SZ_FU, 1024, 0, 0, P.in(12) + i * 1024, 1, base, gw, NGW, scr, lane);
        tr_matrix(P.in(10) + (size_t)i * 2816 * 1024, 2816, 1024, WB + W_FD + (size_t)i * SZ_FD, 2816, 0, 0, nullptr, 0, base, gw, NGW, scr, lane);
        tr_matrix(P.in(14) + (size_t)i * 2816 * 1024, 2816, 1024, WB + W_FD + (size_t)(4 + i) * SZ_FD, 2816, 0, 0, nullptr, 0, base, gw, NGW, scr, lane);
        tr_matrix(P.in(16) + (size_t)i * 256 * 1024, 256, 1024, WB + W_PI + (size_t)i * SZ_PI, 256, 0, 0, nullptr, 0, base, gw, NGW, scr, lane);
        tr_matrix(P.in(17) + (size_t)i * 1024 * 1024, 1024, 1024, WB + W_PG + (size_t)i * SZ_PG, 1024, 0, 0, P.in(15) + i * 1024, 0, base, gw, NGW, scr, lane);
    }
    for (int j = 0; j < 2; ++j) {
        tr_matrix(P.in(19) + (size_t)j * 1024 * 6176, 1024, 6176, WB + W_MI + (size_t)j * SZ_MI, 1024, 0, 0, P.in(11) + (2 * j) * 1024, 0, base, gw, NGW, scr, lane);
        tr_matrix(P.in(26) + (size_t)j * 2048 * 1024, 2048, 1024, WB + W_MO + (size_t)j * SZ_MO, 2048, 0, 0, P.in(25) + j * 2048, 0, base, gw, NGW, scr, lane);
        bf16_t* rk = WB + W_RK + (size_t)j * SZ_RK; const float* mu = P.in(27) + (size_t)j * 6 * 1024;
        tr_matrix(P.in(28) + (size_t)j * 1024 * 1024, 1024, 1024, rk, 2048, 0, 0, nullptr, 0, base, gw, NGW, scr, lane);
        tr_matrix(P.in(28) + (size_t)j * 1024 * 1024, 1024, 1024, rk, 2048, 0, 1024, mu + 0 * 1024, 0, base, gw, NGW, scr, lane);
        tr_matrix(P.in(29) + (size_t)j * 1024 * 1024, 1024, 1024, rk, 2048, 1024, 0, nullptr, 0, base, gw, NGW, scr, lane);
        tr_matrix(P.in(29) + (size_t)j * 1024 * 1024, 1024, 1024, rk, 2048, 1024, 1024, mu + 2 * 1024, 0, base, gw, NGW, scr, lane);
        tr_matrix(P.in(30) + (size_t)j * 1024 * 1024, 1024, 1024, rk, 2048, 2048, 0, nullptr, 0, base, gw, NGW, scr, lane);
        tr_matrix(P.in(30) + (size_t)j * 1024 * 1024, 1024, 1024, rk, 2048, 2048, 1024, mu + 3 * 1024, 0, base, gw, NGW, scr, lane);
        tr_matrix(P.in(33) + (size_t)j * 1024 * 64, 1024, 64, rk, 2048, 3072, 0, nullptr, 0, base, gw, NGW, scr, lane);
        tr_matrix(P.in(33) + (size_t)j * 1024 * 64, 1024, 64, rk, 2048, 3072, 1024, mu + 1 * 1024, 0, base, gw, NGW, scr, lane);
        tr_matrix(P.in(36) + (size_t)j * 1024 * 64, 1024, 64, rk, 2048, 3136, 0, nullptr, 0, base, gw, NGW, scr, lane);
        tr_matrix(P.in(36) + (size_t)j * 1024 * 64, 1024, 64, rk, 2048, 3136, 1024, mu + 4 * 1024, 0, base, gw, NGW, scr, lane);
        tr_matrix(P.in(38) + (size_t)j * 1024 * 160, 1024, 160, rk, 2048, 3200, 0, nullptr, 0, base, gw, NGW, scr, lane);
        tr_matrix(P.in(38) + (size_t)j * 1024 * 160, 1024, 160, rk, 2048, 3200, 1024, mu + 5 * 1024, 0, base, gw, NGW, scr, lane);
        if (j == 1) {
            tr_matrix(P.in(46), 1024, 32, rk, 2048, 3360, 0, nullptr, 0, base, gw, NGW, scr, lane);
            tr_matrix(P.in(46), 1024, 32, rk, 2048, 3360, 1024, mu + 3 * 1024, 0, base, gw, NGW, scr, lane);
        }
        tr_matrix(P.in(31) + (size_t)j * 1024 * 1024, 1024, 1024, WB + W_RO + (size_t)j * SZ_RO, 1024, 0, 0, nullptr, 0, base, gw, NGW, scr, lane);
    }
    const size_t gt = (size_t)blockIdx.x * 512 + tid, NT = (size_t)gridDim.x * 512;
    for (size_t e = gt; e < (size_t)2 * 384 * 4096; e += NT) {
        const int n = (int)(e & 4095), k = (int)((e >> 12) % 384), j = (int)(e / ((size_t)384 * 4096));
        const int q = n >> 10, c = n & 1023; float v = 0.f;
        if (q == 0) { if (k < 64) v = P.in(34)[((size_t)j * 64 + k) * 1024 + c]; }
        else if (q == 1) { if (k >= 64 && k < 128) v = P.in(37)[((size_t)j * 64 + (k - 64)) * 1024 + c]; }
        else if (q == 2) { if (k >= 128 && k < 288) v = P.in(39)[((size_t)j * 160 + (k - 128)) * 1024 + c]; }
        else { if (k >= 288 && k < 320 && j == 1) v = P.in(47)[(size_t)(k - 288) * 1024 + c]; }
        WB[W_L2 + (size_t)j * SZ_L2 + (size_t)n * 384 + k] = (bf16_t)(cvt_pk_bf16(v, 0.f) & 0xffffu);
    }
    bf16_t* pb = (bf16_t*)(P.ws() + OFF_PB);
    for (size_t e = gt; e < (size_t)4 * MT * 64; e += NT) {
        const int c4 = (int)(e & 63); const size_t im = e >> 6; const int i = (int)(im / MT), m = (int)(im % MT);
        const float* src = m < MP ? P.in(2) + ((size_t)i * MP + m) * 256 : P.in(3) + ((size_t)i * 512 + (m - MP)) * 256;
        const f32x4 v = __builtin_nontemporal_load((const f32x4*)(src + c4 * 4));
        u32x2 w; w.x = cvt_pk_bf16(v[0], v[1]); w.y = cvt_pk_bf16(v[2], v[3]);
        *(u32x2*)(pb + im * 256 + c4 * 4) = w;
    }
    float* ss = (float*)(P.ws() + OFF_SS);
    bf16_t* hb = (bf16_t*)(P.ws() + OFF_HB);
    for (int m = gw; m < MT; m += NGW) {
        const float* src = m < MP ? P.in(0) + (size_t)m * 1024 : P.in(1) + (size_t)(m - MP) * 1024;
        float q = 0.f;
#pragma unroll
        for (int jj = 0; jj < 4; ++jj) { const int c = 4 * lane + 256 * jj; const f32x4 v = __builtin_nontemporal_load((const f32x4*)(src + c));
            u32x2 w; w.x = cvt_pk_bf16(v[0], v[1]); w.y = cvt_pk_bf16(v[2], v[3]); *(u32x2*)(hb + (size_t)m * 1024 + c) = w;
            const float r0 = __builtin_bit_cast(float, w.x << 16), r1 = __builtin_bit_cast(float, w.x & 0xffff0000u), r2 = __builtin_bit_cast(float, w.y << 16), r3 = __builtin_bit_cast(float, w.y & 0xffff0000u);
            q += (r0 * r0 + r1 * r1) + (r2 * r2 + r3 * r3); }
        q = wave_sum(q);
        if (lane < 16) ss[(size_t)m * 16 + lane] = lane == 0 ? q : 0.f;
    }
}

template <bool PROMPT>
__device__ __forceinline__ void ssd_unit(const KA P, int j, int row0, int hd, const float* st0, float* stout, const float* cb0, LAS unsigned char* lds) {
    constexpr int T = 32, L = PROMPT ? SEQ : LS, NW = T / 2 + 3;
    int tid_ = threadIdx.x; asm volatile("" : "+v"(tid_)); const int tid = tid_;
    typedef float f32x2 __attribute__((ext_vector_type(2)));
    LAS float* xs = (LAS float*)lds;
    LAS float* Bs = xs + T * 64;
    LAS float* Cs = Bs + T * 128;
    LAS float* dts = Cs + T * 128;
    LAS float* dAs = dts + T;
    LAS float* ys = dAs + T;
    const bf16_t* zx = (const bf16_t*)(P.ws() + OFF_SCR + S_ZX);
    const float* dtraw = (const float*)(P.ws() + OFF_SCR + S_DTR);
    bf16_t* yb = (bf16_t*)(P.ws() + OFF_SCR + S_YB);
    const float* cw = P.in(20) + (size_t)j * 4 * 4096; const float* cbias = P.in(21) + (size_t)j * 4096;
    const int g = hd >> 2;
    const float Ah = -__expf(P.in(23)[j * 32 + hd]), Dh = P.in(24)[j * 32 + hd], dtb = P.in(22)[j * 32 + hd];
    const int p = tid >> 3, nq = tid & 7;
    f32x2 S2[8];
    if (!PROMPT) {
#pragma unroll
        for (int q = 0; q < 4; ++q) { const f32x4 v = __builtin_nontemporal_load((const f32x4*)(st0 + p * 128 + 32 * q + 4 * nq)); S2[2 * q] = (f32x2){v[0], v[1]}; S2[2 * q + 1] = (f32x2){v[2], v[3]}; }
    } else {
#pragma unroll
        for (int q = 0; q < 8; ++q) S2[q] = (f32x2){0.f, 0.f};
    }
    const int cp = tid % 160, th = tid / 160, c0 = 2 * cp;
    const int chn = c0 < 64 ? hd * 64 + c0 : (c0 < 192 ? 2048 + g * 128 + (c0 - 64) : 3072 + g * 128 + (c0 - 192));
    LAS float* sdst = c0 < 64 ? xs + c0 : (c0 < 192 ? Bs + (c0 - 64) : Cs + (c0 - 192));
    const int sstr = c0 < 64 ? 64 : 128;
    float cwr[4][2], cbr[2];
#pragma unroll
    for (int k = 0; k < 4; ++k) { const f32x2 wv = *(const f32x2*)(cw + k * 4096 + chn); cwr[k][0] = wv.x; cwr[k][1] = wv.y; }
    { const f32x2 bv = *(const f32x2*)(cbias + chn); cbr[0] = bv.x; cbr[1] = bv.y; }
    if (PROMPT) {
        unsigned zw[NW]; float dtn = 0.f;
        const int tb = th * (T / 2);
        const bool stg = tid < 320, dtt = tid >= 320 && tid < 320 + T;
        if (stg) {
#pragma unroll
            for (int r = 0; r < NW; ++r) { const int tt = tb - 3 + r; zw[r] = *(const unsigned*)(zx + (size_t)(row0 + (tt < 0 ? 0 : tt)) * 6144 + 2048 + chn); }
        }
        if (dtt) dtn = dtraw[(size_t)(row0 + tid - 320) * 32 + hd];
        for (int t0 = 0; t0 < L; t0 += T) {
            __syncthreads();
            if (dtt) { const float dtv = softplus_f(dtn + dtb); dts[tid - 320] = dtv; dAs[tid - 320] = __expf(dtv * Ah); }
            if (stg) {
                f32x2 win[NW];
#pragma unroll
                for (int r = 0; r < NW; ++r) { f32x2 zf; zf.x = __builtin_bit_cast(float, zw[r] << 16); zf.y = __builtin_bit_cast(float, zw[r] & 0xffff0000u);
                    win[r] = (t0 + tb - 3 + r) >= 0 ? zf : (f32x2){0.f, 0.f}; }
#pragma unroll
                for (int r = 0; r < T / 2; ++r) {
                    float v0 = cbr[0] + cwr[0][0] * win[r].x + cwr[1][0] * win[r + 1].x + cwr[2][0] * win[r + 2].x + cwr[3][0] * win[r + 3].x;
                    float v1 = cbr[1] + cwr[0][1] * win[r].y + cwr[1][1] * win[r + 1].y + cwr[2][1] * win[r + 2].y + cwr[3][1] * win[r + 3].y;
                    *(LAS f32x2*)(sdst + (tb + r) * sstr) = (f32x2){silu_f(v0), silu_f(v1)}; }
            }
            if (t0 + T < L) {
                if (stg) {
#pragma unroll
                    for (int r = 0; r < NW; ++r) zw[r] = *(const unsigned*)(zx + (size_t)(row0 + t0 + T + tb - 3 + r) * 6144 + 2048 + chn);
                }
                if (dtt) dtn = dtraw[(size_t)(row0 + t0 + T + tid - 320) * 32 + hd];
            }
            __syncthreads();
#pragma unroll 4
            for (int t = 0; t < T; ++t) {
                const float x = xs[t * 64 + p], dA = dAs[t], xdt = x * dts[t];
                f32x2 acc2 = (f32x2){0.f, 0.f};
#pragma unroll
                for (int q = 0; q < 4; ++q) {
                    const f32x4 b4 = *(const LAS f32x4*)(Bs + t * 128 + 32 * q + 4 * nq), c4 = *(const LAS f32x4*)(Cs + t * 128 + 32 * q + 4 * nq);
                    S2[2 * q] = S2[2 * q] * dA + (f32x2){b4[0], b4[1]} * xdt; acc2 += S2[2 * q] * (f32x2){c4[0], c4[1]};
                    S2[2 * q + 1] = S2[2 * q + 1] * dA + (f32x2){b4[2], b4[3]} * xdt; acc2 += S2[2 * q + 1] * (f32x2){c4[2], c4[3]};
                }
                float acc = red8(acc2.x + acc2.y);
                if (nq == 0) ys[t * 64 + p] = acc + Dh * x;
            }
            __syncthreads();
            for (int e = tid; e < T * 32; e += 512) { const int t = e >> 5, pp = (e & 31) * 2;
                *(unsigned*)(yb + (size_t)(row0 + t0 + t) * 2048 + hd * 64 + pp) = cvt_pk_bf16(ys[t * 64 + pp], ys[t * 64 + pp + 1]); }
        }
    } else {
        constexpr int nt = LS, nh = nt / 2;
        const int tb = th * nh;
        __syncthreads();
        if (tid >= 320 && tid - 320 < nt) { const int t = tid - 320; const float dtv = softplus_f(dtraw[(size_t)(row0 + t) * 32 + hd] + dtb); dts[t] = dtv; dAs[t] = __expf(dtv * Ah); }
        if (tid < 320) {
#pragma unroll
            for (int r0 = 0; r0 < nh; ++r0) { const int t = tb + r0; float v0 = cbr[0], v1 = cbr[1];
#pragma unroll
                for (int k = 0; k < 4; ++k) { const int tt = t - 3 + k; const int zr = tt < 0 ? 0 : tt;
                    const unsigned zv = *(const unsigned*)(zx + (size_t)(row0 + zr) * 6144 + 2048 + chn);
                    const int cr = tt < 0 ? 3 + tt : 2;
                    const f32x2 cv = *(const f32x2*)(cb0 + cr * 4096 + chn);
                    f32x2 zf; zf.x = __builtin_bit_cast(float, zv << 16); zf.y = __builtin_bit_cast(float, zv & 0xffff0000u);
                    const f32x2 xin = tt >= 0 ? zf : cv;
                    v0 += cwr[k][0] * xin.x; v1 += cwr[k][1] * xin.y; }
                *(LAS f32x2*)(sdst + t * sstr) = (f32x2){silu_f(v0), silu_f(v1)}; }
        }
        __syncthreads();
#pragma unroll
        for (int t = 0; t < nt; ++t) {
            const float x = xs[t * 64 + p], dA = dAs[t], xdt = x * dts[t];
            f32x2 acc2 = (f32x2){0.f, 0.f};
#pragma unroll
            for (int q = 0; q < 4; ++q) {
                const f32x4 b4 = *(const LAS f32x4*)(Bs + t * 128 + 32 * q + 4 * nq), c4 = *(const LAS f32x4*)(Cs + t * 128 + 32 * q + 4 * nq);
                S2[2 * q] = S2[2 * q] * dA + (f32x2){b4[0], b4[1]} * xdt; acc2 += S2[2 * q] * (f32x2){c4[0], c4[1]};
                S2[2 * q + 1] = S2[2 * q + 1] * dA + (f32x2){b4[2], b4[3]} * xdt; acc2 += S2[2 * q + 1] * (f32x2){c4[2], c4[3]};
            }
            float acc = red8(acc2.x + acc2.y);
            if (nq == 0) ys[t * 64 + p] = acc + Dh * x;
        }
        __syncthreads();
        for (int e = tid; e < nt * 32; e += 512) { const int t = e >> 5, pp = (e & 31) * 2;
            *(unsigned*)(yb + (size_t)(row0 + t) * 2048 + hd * 64 + pp) = cvt_pk_bf16(ys[t * 64 + pp], ys[t * 64 + pp + 1]); }
    }
#pragma unroll
    for (int q = 0; q < 4; ++q) __builtin_nontemporal_store((f32x4){S2[2 * q].x, S2[2 * q].y, S2[2 * q + 1].x, S2[2 * q + 1].y}, (f32x4*)(stout + p * 128 + 32 * q + 4 * nq));
}

#ifndef MK_SSD_MFMA
#define MK_SSD_MFMA 1
#endif
__device__ __forceinline__ void ssd_unit_mfma(const KA P, int j, int row0, int hd, float* stout, LAS unsigned char* lds) {
    constexpr int Q = 64, NCH = SEQ / Q, RS = 272, RT = 144;
    int tid_ = threadIdx.x; asm volatile("" : "+v"(tid_)); const int tid = tid_, lane = tid & 63, wid = tid >> 6, fr = lane & 15, fq = lane >> 4;
    typedef float f32x2 __attribute__((ext_vector_type(2)));
    typedef short bf16x8_t __attribute__((ext_vector_type(8)));
    LAS unsigned char* Cs = lds;
    LAS unsigned char* Bs = Cs + 64 * RS;
    LAS unsigned char* Sb = Bs + 64 * RS;
    LAS unsigned char* Bt = Sb + 64 * RS;
    LAS unsigned char* Xt = Bt + 128 * RT;
    LAS unsigned char* Xst = Xt + 64 * RT;
    LAS unsigned char* Mm = Xst + 64 * RT;
    LAS float* ys = (LAS float*)(Mm + 64 * RT);
    LAS float* dtb_ = ys + 64 * 64;
    LAS float* dtq = dtb_ + 2 * 4 * 64;
    const bf16_t* zx = (const bf16_t*)(P.ws() + OFF_SCR + S_ZX);
    const float* dtraw = (const float*)(P.ws() + OFF_SCR + S_DTR);
    bf16_t* yb = (bf16_t*)(P.ws() + OFF_SCR + S_YB);
    const float* cw = P.in(20) + (size_t)j * 4 * 4096; const float* cbias = P.in(21) + (size_t)j * 4096;
    const int g = hd >> 2;
    const float Ah = -__expf(P.in(23)[j * 32 + hd]), Dh = P.in(24)[j * 32 + hd], dtbias = P.in(22)[j * 32 + hd];
    int chn[2], c0s[2], qts[2]; float cwr[2][4][2], cbr[2][2];
#pragma unroll
    for (int s = 0; s < 2; ++s) { const int it = tid + 512 * s; const int cp = it % 160; qts[s] = it / 160; const int c0 = 2 * cp; c0s[s] = c0;
        chn[s] = c0 < 64 ? hd * 64 + c0 : (c0 < 192 ? 2048 + g * 128 + (c0 - 64) : 3072 + g * 128 + (c0 - 192));
#pragma unroll
        for (int k = 0; k < 4; ++k) { const f32x2 wv = *(const f32x2*)(cw + k * 4096 + chn[s]); cwr[s][k][0] = wv.x; cwr[s][k][1] = wv.y; }
        const f32x2 bv = *(const f32x2*)(cbias + chn[s]); cbr[s][0] = bv.x; cbr[s][1] = bv.y; }
    const bool has2 = tid < 128;
    unsigned zw[2][19]; float dtn = 0.f;
    for (int e = tid; e < 64 * RS / 4; e += 512) ((LAS unsigned*)Sb)[e] = 0u;
#pragma unroll
    for (int s = 0; s < 2; ++s) if (s == 0 || has2) {
#pragma unroll
        for (int r = 0; r < 19; ++r) { const int tt = 16 * qts[s] - 3 + r; zw[s][r] = *(const unsigned*)(zx + (size_t)(row0 + (tt < 0 ? 0 : tt)) * 6144 + 2048 + chn[s]); } }
    if (wid == 7) dtn = dtraw[(size_t)(row0 + lane) * 32 + hd];
    f32x4 accS[4];
#pragma unroll
    for (int k = 0; k < 4; ++k) accS[k] = (f32x4){0.f, 0.f, 0.f, 0.f};
#define SSD_DTPREFIX(cbuf) do { if (wid == 7) { const float dtv = softplus_f(dtn + dtbias); float a = dtv * Ah; \
        _Pragma("unroll") for (int o = 1; o < 64; o <<= 1) { const float up = __shfl_up(a, o); if (lane >= o) a += up; } \
        const float aQ = __shfl(a, 63); LAS float* d = dtb_ + (cbuf) * 256; d[lane] = a; d[64 + lane] = __expf(a); d[128 + lane] = __expf(aQ - a) * dtv; d[192 + lane] = dtv; \
        if (lane == 0) dtq[(cbuf)] = __expf(aQ); } } while (0)
    SSD_DTPREFIX(0);
    __syncthreads();
    for (int c = 0; c < NCH; ++c) {
        const int t0 = c * Q; LAS float* dcur = dtb_ + (c & 1) * 256;
#pragma unroll
        for (int s = 0; s < 2; ++s) if (s == 0 || has2) {
            const int c0 = c0s[s], qt = qts[s];
            f32x2 win[19];
#pragma unroll
            for (int r = 0; r < 19; ++r) { f32x2 zf; zf.x = __builtin_bit_cast(float, zw[s][r] << 16); zf.y = __builtin_bit_cast(float, zw[s][r] & 0xffff0000u);
                win[r] = (t0 + 16 * qt - 3 + r) >= 0 ? zf : (f32x2){0.f, 0.f}; }
            float v0[16], v1[16];
#pragma unroll
            for (int r = 0; r < 16; ++r) {
                const float a0 = cbr[s][0] + cwr[s][0][0] * win[r].x + cwr[s][1][0] * win[r + 1].x + cwr[s][2][0] * win[r + 2].x + cwr[s][3][0] * win[r + 3].x;
                const float a1 = cbr[s][1] + cwr[s][0][1] * win[r].y + cwr[s][1][1] * win[r + 1].y + cwr[s][2][1] * win[r + 2].y + cwr[s][3][1] * win[r + 3].y;
                v0[r] = a0 * __builtin_amdgcn_rcpf(1.f + __expf(-a0)); v1[r] = a1 * __builtin_amdgcn_rcpf(1.f + __expf(-a1)); }
            if (c0 < 64) {
                u32x4 w;
                w.x = cvt_pk_bf16(v0[0], v0[1]); w.y = cvt_pk_bf16(v0[2], v0[3]); w.z = cvt_pk_bf16(v0[4], v0[5]); w.w = cvt_pk_bf16(v0[6], v0[7]); *(LAS u32x4*)(Xt + c0 * RT + qt * 32) = w;
                w.x = cvt_pk_bf16(v0[8], v0[9]); w.y = cvt_pk_bf16(v0[10], v0[11]); w.z = cvt_pk_bf16(v0[12], v0[13]); w.w = cvt_pk_bf16(v0[14], v0[15]); *(LAS u32x4*)(Xt + c0 * RT + qt * 32 + 16) = w;
                w.x = cvt_pk_bf16(v1[0], v1[1]); w.y = cvt_pk_bf16(v1[2], v1[3]); w.z = cvt_pk_bf16(v1[4], v1[5]); w.w = cvt_pk_bf16(v1[6], v1[7]); *(LAS u32x4*)(Xt + (c0 + 1) * RT + qt * 32) = w;
                w.x = cvt_pk_bf16(v1[8], v1[9]); w.y = cvt_pk_bf16(v1[10], v1[11]); w.z = cvt_pk_bf16(v1[12], v1[13]); w.w = cvt_pk_bf16(v1[14], v1[15]); *(LAS u32x4*)(Xt + (c0 + 1) * RT + qt * 32 + 16) = w;
                float s0[16], s1[16];
#pragma unroll
                for (int r = 0; r < 16; ++r) { const float w1 = dcur[128 + 16 * qt + r]; s0[r] = v0[r] * w1; s1[r] = v1[r] * w1; }
                w.x = cvt_pk_bf16(s0[0], s0[1]); w.y = cvt_pk_bf16(s0[2], s0[3]); w.z = cvt_pk_bf16(s0[4], s0[5]); w.w = cvt_pk_bf16(s0[6], s0[7]); *(LAS u32x4*)(Xst + c0 * RT + qt * 32) = w;
                w.x = cvt_pk_bf16(s0[8], s0[9]); w.y = cvt_pk_bf16(s0[10], s0[11]); w.z = cvt_pk_bf16(s0[12], s0[13]); w.w = cvt_pk_bf16(s0[14], s0[15]); *(LAS u32x4*)(Xst + c0 * RT + qt * 32 + 16) = w;
                w.x = cvt_pk_bf16(s1[0], s1[1]); w.y = cvt_pk_bf16(s1[2], s1[3]); w.z = cvt_pk_bf16(s1[4], s1[5]); w.w = cvt_pk_bf16(s1[6], s1[7]); *(LAS u32x4*)(Xst + (c0 + 1) * RT + qt * 32) = w;
                w.x = cvt_pk_bf16(s1[8], s1[9]); w.y = cvt_pk_bf16(s1[10], s1[11]); w.z = cvt_pk_bf16(s1[12], s1[13]); w.w = cvt_pk_bf16(s1[14], s1[15]); *(LAS u32x4*)(Xst + (c0 + 1) * RT + qt * 32 + 16) = w;
            } else {
                const bool isB = c0 < 192; const int n = isB ? c0 - 64 : c0 - 192; LAS unsigned char* nat = isB ? Bs : Cs;
#pragma unroll
                for (int r = 0; r < 16; ++r) *(LAS unsigned*)(nat + (16 * qt + r) * RS + n * 2) = cvt_pk_bf16(v0[r], v1[r]);
                if (isB) { u32x4 w;
                    w.x = cvt_pk_bf16(v0[0], v0[1]); w.y = cvt_pk_bf16(v0[2], v0[3]); w.z = cvt_pk_bf16(v0[4], v0[5]); w.w = cvt_pk_bf16(v0[6], v0[7]); *(LAS u32x4*)(Bt + n * RT + qt * 32) = w;
                    w.x = cvt_pk_bf16(v0[8], v0[9]); w.y = cvt_pk_bf16(v0[10], v0[11]); w.z = cvt_pk_bf16(v0[12], v0[13]); w.w = cvt_pk_bf16(v0[14], v0[15]); *(LAS u32x4*)(Bt + n * RT + qt * 32 + 16) = w;
                    w.x = cvt_pk_bf16(v1[0], v1[1]); w.y = cvt_pk_bf16(v1[2], v1[3]); w.z = cvt_pk_bf16(v1[4], v1[5]); w.w = cvt_pk_bf16(v1[6], v1[7]); *(LAS u32x4*)(Bt + (n + 1) * RT + qt * 32) = w;
                    w.x = cvt_pk_bf16(v1[8], v1[9]); w.y = cvt_pk_bf16(v1[10], v1[11]); w.z = cvt_pk_bf16(v1[12], v1[13]); w.w = cvt_pk_bf16(v1[14], v1[15]); *(LAS u32x4*)(Bt + (n + 1) * RT + qt * 32 + 16) = w; }
            }
        }
        if (c + 1 < NCH) {
#pragma unroll
            for (int s = 0; s < 2; ++s) if (s == 0 || has2) {
#pragma unroll
                for (int r = 0; r < 19; ++r) zw[s][r] = *(const unsigned*)(zx + (size_t)(row0 + t0 + Q + 16 * qts[s] - 3 + r) * 6144 + 2048 + chn[s]); }
            if (wid == 7) dtn = dtraw[(size_t)(row0 + t0 + Q + lane) * 32 + hd];
        }
        __syncthreads();
        { const int it = wid >> 1;
#pragma unroll
          for (int u = 0; u < 2; ++u) { const int jt = (wid & 1) * 2 + u;
            f32x4 gacc = (f32x4){0.f, 0.f, 0.f, 0.f};
            if (jt <= it) {
#pragma unroll
                for (int ks = 0; ks < 4; ++ks) { const bf16x8_t ca = *(const LAS bf16x8_t*)(Cs + (16 * it + fr) * RS + (32 * ks + 8 * fq) * 2), bb = *(const LAS bf16x8_t*)(Bs + (16 * jt + fr) * RS + (32 * ks + 8 * fq) * 2);
                    gacc = __builtin_amdgcn_mfma_f32_16x16x32_bf16(ca, bb, gacc, 0, 0, 0); }
            }
            const int jj = 16 * jt + fr; const float aj = dcur[jj], dj = dcur[192 + jj];
#pragma unroll
            for (int r = 0; r < 4; ++r) { const int ii = 16 * it + 4 * fq + r; const float ai = dcur[ii];
                const float mv = (jj <= ii) ? gacc[r] * __expf(ai - aj) * dj : 0.f;
                *(LAS unsigned short*)(Mm + ii * RT + jj * 2) = (unsigned short)(cvt_pk_bf16(mv, 0.f) & 0xffffu); }
          } }
        __syncthreads();
        { const int it = wid >> 1;
#pragma unroll
          for (int u = 0; u < 2; ++u) { const int pt = (wid & 1) * 2 + u;
            f32x4 ya = (f32x4){0.f, 0.f, 0.f, 0.f}, yi = (f32x4){0.f, 0.f, 0.f, 0.f};
#pragma unroll
            for (int ks = 0; ks < 2; ++ks) if (32 * ks <= 16 * it + 15) { const bf16x8_t ma = *(const LAS bf16x8_t*)(Mm + (16 * it + fr) * RT + (32 * ks + 8 * fq) * 2), xb = *(const LAS bf16x8_t*)(Xt + (16 * pt + fr) * RT + (32 * ks + 8 * fq) * 2);
                ya = __builtin_amdgcn_mfma_f32_16x16x32_bf16(ma, xb, ya, 0, 0, 0); }
#pragma unroll
            for (int ks = 0; ks < 4; ++ks) { const bf16x8_t ca = *(const LAS bf16x8_t*)(Cs + (16 * it + fr) * RS + (32 * ks + 8 * fq) * 2), sb = *(const LAS bf16x8_t*)(Sb + (16 * pt + fr) * RS + (32 * ks + 8 * fq) * 2);
                yi = __builtin_amdgcn_mfma_f32_16x16x32_bf16(ca, sb, yi, 0, 0, 0); }
            const int pp = 16 * pt + fr;
#pragma unroll
            for (int r = 0; r < 4; ++r) { const int ii = 16 * it + 4 * fq + r;
                const float xv = bf2f(*(const LAS unsigned short*)(Xt + pp * RT + ii * 2));
                ys[ii * 64 + pp] = ya[r] + dcur[64 + ii] * yi[r] + Dh * xv; }
          } }
        { const int pt = wid >> 1; const float eq = dtq[c & 1];
#pragma unroll
          for (int k = 0; k < 4; ++k) { const int nt = (wid & 1) * 4 + k;
            accS[k] = accS[k] * eq;
#pragma unroll
            for (int ks = 0; ks < 2; ++ks) { const bf16x8_t xa = *(const LAS bf16x8_t*)(Xst + (16 * pt + fr) * RT + (32 * ks + 8 * fq) * 2), bb = *(const LAS bf16x8_t*)(Bt + (16 * nt + fr) * RT + (32 * ks + 8 * fq) * 2);
                accS[k] = __builtin_amdgcn_mfma_f32_16x16x32_bf16(xa, bb, accS[k], 0, 0, 0); }
          } }
        if (c + 1 < NCH) SSD_DTPREFIX((c + 1) & 1);
        __syncthreads();
        { const int pt = wid >> 1;
#pragma unroll
          for (int k = 0; k < 4; ++k) { const int nn = 16 * ((wid & 1) * 4 + k) + fr;
#pragma unroll
            for (int r = 0; r < 4; ++r) *(LAS unsigned short*)(Sb + (16 * pt + 4 * fq + r) * RS + nn * 2) = (unsigned short)(cvt_pk_bf16(accS[k][r], 0.f) & 0xffffu); } }
        { const int t = tid >> 3, p8 = (tid & 7) * 8; const f32x4 ya = *(const LAS f32x4*)(ys + t * 64 + p8), yc = *(const LAS f32x4*)(ys + t * 64 + p8 + 4);
          u32x4 w; w.x = cvt_pk_bf16(ya[0], ya[1]); w.y = cvt_pk_bf16(ya[2], ya[3]); w.z = cvt_pk_bf16(yc[0], yc[1]); w.w = cvt_pk_bf16(yc[2], yc[3]);
          *(u32x4*)(yb + (size_t)(row0 + t0 + t) * 2048 + hd * 64 + p8) = w; }
    }
#undef SSD_DTPREFIX
    { const int pt = wid >> 1;
#pragma unroll
      for (int k = 0; k < 4; ++k) { const int nn = 16 * ((wid & 1) * 4 + k) + fr;
#pragma unroll
        for (int r = 0; r < 4; ++r) __builtin_nontemporal_store(accS[k][r], stout + (16 * pt + 4 * fq + r) * 128 + nn); } }
    __syncthreads();
}

__device__ __forceinline__ void phase_ssd(const KA P, int j, LAS unsigned char* lds) {
    {
        const bf16_t* zx = (const bf16_t*)(P.ws() + OFF_SCR + S_ZX);
        int tid2_ = threadIdx.x; asm volatile("" : "+v"(tid2_)); const size_t gt = (size_t)blockIdx.x * 512 + tid2_, NT = (size_t)gridDim.x * 512;
        for (size_t e = gt; e < (size_t)(BP + BS) * 3 * 4096; e += NT) {
            const int ch = (int)(e & 4095), r = (int)((e >> 12) % 3), b = (int)(e / (3 * 4096));
            if (b < BP) P.out()[O_CONVP + ((size_t)(j * BP + b) * 3 + r) * 4096 + ch] = bf2f(zx[(size_t)(b * SEQ + SEQ - 3 + r) * 6144 + 2048 + ch]);
            else { const int bs = b - BP; P.out()[O_CONVS + ((size_t)(j * BS + bs) * 3 + r) * 4096 + ch] = bf2f(zx[(size_t)(MP + bs * LS + LS - 3 + r) * 6144 + 2048 + ch]); }
        }
    }
    for (int u = blockIdx.x; u < 256 + 4096; u += gridDim.x) {
        if (u < 256) { const int b = u >> 5, hd = u & 31;
            if (MK_SSD_MFMA) ssd_unit_mfma(P, j, b * SEQ, hd, P.out() + O_SSMP + ((size_t)(j * BP + b) * 32 + hd) * 8192, lds);
            else ssd_unit<true>(P, j, b * SEQ, hd, nullptr, P.out() + O_SSMP + ((size_t)(j * BP + b) * 32 + hd) * 8192, nullptr, lds);
        } else { const int b = (u - 256) >> 5, hd = u & 31;
            ssd_unit<false>(P, j, MP + b * LS, hd, P.in(4) + ((size_t)(j * BS + b) * 32 + hd) * 8192, P.out() + O_SSMS + ((size_t)(j * BS + b) * 32 + hd) * 8192,
                     P.in(5) + (size_t)(j * BS + b) * 3 * 4096, lds);
        }
    }
}
__device__ __forceinline__ void phase_mgate(const KA P) {
    int tid_ = threadIdx.x; asm volatile("" : "+v"(tid_)); const int lane = tid_ & 63, gw = blockIdx.x * 8 + (tid_ >> 6), NGW = gridDim.x * 8;
    const bf16_t* zx = (const bf16_t*)(P.ws() + OFF_SCR + S_ZX);
    bf16_t* yb = (bf16_t*)(P.ws() + OFF_SCR + S_YB);
    for (int m = gw; m < MT; m += NGW) {
        float v[32]; float q = 0.f;
#pragma unroll
        for (int c = 0; c < 4; ++c) {
            const u32x4 yv = *(const u32x4*)(yb + (size_t)m * 2048 + lane * 32 + c * 8), zv = *(const u32x4*)(zx + (size_t)m * 6144 + lane * 32 + c * 8);
#pragma unroll
            for (int e = 0; e < 4; ++e) {
                const float y0 = __builtin_bit_cast(float, yv[e] << 16), y1 = __builtin_bit_cast(float, yv[e] & 0xffff0000u);
                const float z0 = __builtin_bit_cast(float, zv[e] << 16), z1 = __builtin_bit_cast(float, zv[e] & 0xffff0000u);
                const float a = y0 * silu_f(z0), b = y1 * silu_f(z1);
                v[c * 8 + 2 * e] = a; v[c * 8 + 2 * e + 1] = b; q += a * a + b * b;
            }
        }
        q = red8(q);
        const float sc = rsqrtf(q * (1.f / 256.f) + 1e-5f);
#pragma unroll
        for (int c = 0; c < 4; ++c) { u32x4 w;
#pragma unroll
            for (int e = 0; e < 4; ++e) w[e] = cvt_pk_bf16(v[c * 8 + 2 * e] * sc, v[c * 8 + 2 * e + 1] * sc);
            *(u32x4*)(yb + (size_t)m * 2048 + lane * 32 + c * 8) = w; }
    }
}

__device__ __forceinline__ void phase_umix(const KA P, int i, int j) {
    int tid_ = threadIdx.x; asm volatile("" : "+v"(tid_)); const int lane = tid_ & 63, gw = blockIdx.x * 8 + (tid_ >> 6), NGW = gridDim.x * 8;
    const bf16_t* h = (const bf16_t*)(P.ws() + OFF_HB); const float* ss = (const float*)(P.ws() + OFF_SS) + (size_t)(4 * i + 1) * MT * 16;
    const float* gn = P.in(11) + (size_t)i * 1024;
    bf16_t* A2 = (bf16_t*)(P.ws() + OFF_SCR + S_A2);
    for (int m = gw; m < MT; m += NGW) {
        const bool pr = m < MP; const int t = pr ? (m & (SEQ - 1)) : ((m - MP) & (LS - 1)); const int b = pr ? (m >> 11) : ((m - MP) >> 2);
        const float s = pg8::rowscale(ss, m); const float sp = t > 0 ? pg8::rowscale(ss, m - 1) : 0.f;
        const bool last = pr ? (t == SEQ - 1) : (t == LS - 1);
        float* sho = pr ? P.out() + O_SHP + (size_t)(j * BP + b) * 1024 : P.out() + O_SHS + (size_t)(j * BS + b) * 1024;
#pragma unroll
        for (int jj = 0; jj < 4; ++jj) { const int c = 4 * lane + 256 * jj;
            const f32x4 gv = *(const f32x4*)(gn + c); const u32x2 hw_ = *(const u32x2*)(h + (size_t)m * 1024 + c);
            f32x4 hv; hv[0] = __builtin_bit_cast(float, hw_.x << 16); hv[1] = __builtin_bit_cast(float, hw_.x & 0xffff0000u); hv[2] = __builtin_bit_cast(float, hw_.y << 16); hv[3] = __builtin_bit_cast(float, hw_.y & 0xffff0000u);
            f32x4 u = hv * gv * s, up;
            if (t > 0) { const u32x2 hq_ = *(const u32x2*)(h + (size_t)(m - 1) * 1024 + c); f32x4 hp; hp[0] = __builtin_bit_cast(float, hq_.x << 16); hp[1] = __builtin_bit_cast(float, hq_.x & 0xffff0000u); hp[2] = __builtin_bit_cast(float, hq_.y << 16); hp[3] = __builtin_bit_cast(float, hq_.y & 0xffff0000u); up = hp * gv * sp; }
            else if (pr) up = (f32x4){0.f, 0.f, 0.f, 0.f};
            else up = *(const f32x4*)(P.in(7) + (size_t)(j * BS + b) * 1024 + c);
            const f32x4 xx = up - u;
            u32x2 w; w.x = cvt_pk_bf16(u[0], u[1]); w.y = cvt_pk_bf16(u[2], u[3]); *(u32x2*)(A2 + (size_t)m * 2048 + c) = w;
            w.x = cvt_pk_bf16(xx[0], xx[1]); w.y = cvt_pk_bf16(xx[2], xx[3]); *(u32x2*)(A2 + (size_t)m * 2048 + 1024 + c) = w;
            if (last) *(f32x4*)(sho + c) = u;
        }
    }
}
__device__ __forceinline__ void wkv_unit(const KA P, int j, int row0, int L, int hd, int half, const float* st0, float* stout, LAS unsigned char* lds) {
    constexpr int T = 32, BUF = 5 * T * 64 + T * 32;
    typedef float f32x2 __attribute__((ext_vector_type(2)));
    int tid_ = threadIdx.x; asm volatile("" : "+v"(tid_)); const int tid = tid_;
    const bool scanner = tid < 256; const int lt = tid & 255;
    LAS float* buf0 = (LAS float*)lds;
    LAS float* ysb = buf0 + 2 * BUF;
    const unsigned char* scr = P.ws() + OFF_SCR;
    const bf16_t* Rb = (const bf16_t*)(scr + S_R); const bf16_t* Kb = Rb + (size_t)MT * 1024;
    const bf16_t* Vb = j == 0 ? (const bf16_t*)(P.ws() + OFF_VF) : (const bf16_t*)(scr + S_V2);
    const bf16_t* VF = (const bf16_t*)(P.ws() + OFF_VF); const bf16_t* Ab = (const bf16_t*)(scr + S_AA); const bf16_t* VG = Ab + (size_t)2 * MT * 1024;
    const float* Db = (const float*)(scr + S_DD);
    bf16_t* yraw = (bf16_t*)(P.ws() + OFF_SCR + S_A2);
    const int nblk = (L + T - 1) / T;
    const int st = lt >> 3, c8 = (lt & 7) * 8, ch = hd * 64 + c8;
    const int il = lt >> 3, jq = lt & 7;
    f32x2 S[4];
    if (scanner) {
        if (st0) { const f32x4 a = __builtin_nontemporal_load((const f32x4*)(st0 + (half * 32 + il) * 64 + jq * 8)), b = __builtin_nontemporal_load((const f32x4*)(st0 + (half * 32 + il) * 64 + jq * 8 + 4));
            S[0] = (f32x2){a[0], a[1]}; S[1] = (f32x2){a[2], a[3]}; S[2] = (f32x2){b[0], b[1]}; S[3] = (f32x2){b[2], b[3]}; }
        else { S[0] = S[1] = S[2] = S[3] = (f32x2){0.f, 0.f}; }
    }
#define WKV_LOAD(blk) do { const int nt_ = (L - (blk) * T) < T ? (L - (blk) * T) : T; \
        const int tt_ = st < nt_ ? st : nt_ - 1; const size_t o_ = (size_t)(row0 + (blk) * T + tt_) * 1024 + ch; \
        _Pragma("unroll") for (int hh = 0; hh < 2; ++hh) { const size_t oo = o_ + 4 * hh; \
            rr_[hh] = ld_bf4(Rb + oo); kr_[hh] = ld_bf4(Kb + oo); dd_[hh] = *(const f32x4*)(Db + oo); aa_[hh] = ld_bf4(Ab + oo); vv_[hh] = ld_bf4(Vb + oo); \
            if (j == 1) { vf_[hh] = ld_bf4(VF + oo); vg_[hh] = ld_bf4(VG + oo); } } } while (0)
#define WKV_FINISH(blk) do { const int nt_ = (L - (blk) * T) < T ? (L - (blk) * T) : T; LAS float* B_ = buf0 + ((blk) & 1) * BUF; \
        f32x4 kk_[2], kp_[2], v2_[2]; \
        _Pragma("unroll") for (int hh = 0; hh < 2; ++hh) { v2_[hh] = vv_[hh]; if (j == 1) v2_[hh] = vv_[hh] + (vf_[hh] - vv_[hh]) * vg_[hh]; \
            kk_[hh] = kr_[hh] * kkw_[hh]; kp_[hh] = kr_[hh] * (1.f + (aa_[hh] - 1.f) * kaw_[hh]); } \
        float q_ = ((kk_[0][0] * kk_[0][0] + kk_[0][1] * kk_[0][1]) + (kk_[0][2] * kk_[0][2] + kk_[0][3] * kk_[0][3])) + ((kk_[1][0] * kk_[1][0] + kk_[1][1] * kk_[1][1]) + (kk_[1][2] * kk_[1][2] + kk_[1][3] * kk_[1][3])); \
        q_ = red8(q_); const float nrm_ = rsqrtf(fmaxf(q_, 1e-24f)); \
        if (st < nt_) { _Pragma("unroll") for (int hh = 0; hh < 2; ++hh) { const f32x4 kn = kk_[hh] * nrm_; \
            *(LAS f32x4*)(B_ + 0 * T * 64 + st * 64 + c8 + 4 * hh) = rr_[hh]; *(LAS f32x4*)(B_ + 1 * T * 64 + st * 64 + c8 + 4 * hh) = dd_[hh]; \
            *(LAS f32x4*)(B_ + 2 * T * 64 + st * 64 + c8 + 4 * hh) = kp_[hh]; *(LAS f32x4*)(B_ + 3 * T * 64 + st * 64 + c8 + 4 * hh) = kn; \
            *(LAS f32x4*)(B_ + 4 * T * 64 + st * 64 + c8 + 4 * hh) = kn * aa_[hh]; \
            if ((c8 >> 5) == half) *(LAS f32x4*)(B_ + 5 * T * 64 + st * 32 + (c8 & 31) + 4 * hh) = v2_[hh]; } } } while (0)
#define WKV_WRITEOUT(blk) do { const int nt_ = (L - (blk) * T) < T ? (L - (blk) * T) : T; const int t_ = lt >> 3, i4_ = (lt & 7) * 4; \
        if (t_ < nt_) { const f32x4 y_ = *(const LAS f32x4*)(ysb + ((blk) & 1) * T * 32 + t_ * 32 + i4_); u32x2 w_; w_.x = cvt_pk_bf16(y_[0], y_[1]); w_.y = cvt_pk_bf16(y_[2], y_[3]); \
            *(u32x2*)(yraw + (size_t)(row0 + (blk) * T + t_) * 1024 + hd * 64 + half * 32 + i4_) = w_; } } while (0)
    f32x4 rr_[2], dd_[2], vv_[2], kr_[2], aa_[2], vf_[2], vg_[2], kkw_[2], kaw_[2];
    if (!scanner) {
#pragma unroll
        for (int hh = 0; hh < 2; ++hh) { kkw_[hh] = *(const f32x4*)(P.in(40) + (size_t)j * 1024 + ch + 4 * hh); kaw_[hh] = *(const f32x4*)(P.in(41) + (size_t)j * 1024 + ch + 4 * hh); }
        WKV_LOAD(0); WKV_FINISH(0); if (1 < nblk) WKV_LOAD(1); }
    __syncthreads();
    for (int blk = 0; blk < nblk; ++blk) {
        if (scanner) {
            const int nt = (L - blk * T) < T ? (L - blk * T) : T; const LAS float* B_ = buf0 + (blk & 1) * BUF; LAS float* Y_ = ysb + (blk & 1) * T * 32;
#define WKV_LDSTEP(X, tt) do { const LAS float* row = B_ + (tt) * 64 + jq * 8; \
                X[0] = *(const LAS f32x4*)(row + 3 * T * 64); X[1] = *(const LAS f32x4*)(row + 3 * T * 64 + 4); X[2] = *(const LAS f32x4*)(row + 1 * T * 64); X[3] = *(const LAS f32x4*)(row + 1 * T * 64 + 4); \
                X[4] = *(const LAS f32x4*)(row + 4 * T * 64); X[5] = *(const LAS f32x4*)(row + 4 * T * 64 + 4); X[6] = *(const LAS f32x4*)(row + 2 * T * 64); X[7] = *(const LAS f32x4*)(row + 2 * T * 64 + 4); \
                X[8] = *(const LAS f32x4*)(row); X[9] = *(const LAS f32x4*)(row + 4); X##v = B_[5 * T * 64 + (tt) * 32 + il]; } while (0)
            f32x4 cu[10], nx[10]; float cuv, nxv = 0.f;
            WKV_LDSTEP(cu, 0);
#pragma unroll 4
            for (int t = 0; t < nt; ++t) {
                if (t + 1 < nt) WKV_LDSTEP(nx, t + 1);
                f32x2 s2 = S[0] * (f32x2){cu[0][0], cu[0][1]} + S[1] * (f32x2){cu[0][2], cu[0][3]} + S[2] * (f32x2){cu[1][0], cu[1][1]} + S[3] * (f32x2){cu[1][2], cu[1][3]};
                const float sa = -red8(s2.x + s2.y);
                const float vi = cuv;
                S[0] = S[0] * (f32x2){cu[2][0], cu[2][1]} + (f32x2){cu[4][0], cu[4][1]} * sa + (f32x2){cu[6][0], cu[6][1]} * vi;
                S[1] = S[1] * (f32x2){cu[2][2], cu[2][3]} + (f32x2){cu[4][2], cu[4][3]} * sa + (f32x2){cu[6][2], cu[6][3]} * vi;
                S[2] = S[2] * (f32x2){cu[3][0], cu[3][1]} + (f32x2){cu[5][0], cu[5][1]} * sa + (f32x2){cu[7][0], cu[7][1]} * vi;
                S[3] = S[3] * (f32x2){cu[3][2], cu[3][3]} + (f32x2){cu[5][2], cu[5][3]} * sa + (f32x2){cu[7][2], cu[7][3]} * vi;
                f32x2 y2 = S[0] * (f32x2){cu[8][0], cu[8][1]} + S[1] * (f32x2){cu[8][2], cu[8][3]} + S[2] * (f32x2){cu[9][0], cu[9][1]} + S[3] * (f32x2){cu[9][2], cu[9][3]};
                const float y = red8(y2.x + y2.y);
                if (jq == 0) Y_[t * 32 + il] = y;
#pragma unroll
                for (int u = 0; u < 10; ++u) cu[u] = nx[u];
                cuv = nxv;
            }
#undef WKV_LDSTEP
        } else {
            if (blk > 0) WKV_WRITEOUT(blk - 1);
            if (blk + 1 < nblk) { WKV_FINISH(blk + 1); if (blk + 2 < nblk) WKV_LOAD(blk + 2); }
        }
        __syncthreads();
    }
    if (!scanner) WKV_WRITEOUT(nblk - 1);
    else { __builtin_nontemporal_store((f32x4){S[0].x, S[0].y, S[1].x, S[1].y}, (f32x4*)(stout + (half * 32 + il) * 64 + jq * 8)); __builtin_nontemporal_store((f32x4){S[2].x, S[2].y, S[3].x, S[3].y}, (f32x4*)(stout + (half * 32 + il) * 64 + jq * 8 + 4)); }
#undef WKV_LOAD
#undef WKV_FINISH
#undef WKV_WRITEOUT
}
__device__ __forceinline__ void phase_wkv(const KA P, int j, LAS unsigned char* lds) {
    for (int u = blockIdx.x; u < 256 + 4096; u += gridDim.x) {
        if (u < 256) { const int b = u >> 5, hd = (u >> 1) & 15, half = u & 1;
            wkv_unit(P, j, b * SEQ, SEQ, hd, half, nullptr, P.out() + O_WKVP + ((size_t)(j * BP + b) * 16 + hd) * 4096, lds);
        } else { const int v = u - 256; const int b = v >> 5, hd = (v >> 1) & 15, half = v & 1;
            wkv_unit(P, j, MP + b * LS, LS, hd, half, P.in(6) + ((size_t)(j * BS + b) * 16 + hd) * 4096, P.out() + O_WKVS + ((size_t)(j * BS + b) * 16 + hd) * 4096, lds);
        }
    }
}
__device__ __forceinline__ void phase_rpost(const KA P, int j) {
    int tid_ = threadIdx.x; asm volatile("" : "+v"(tid_)); const int lane = tid_ & 63, gw = blockIdx.x * 8 + (tid_ >> 6), NGW = gridDim.x * 8;
    const unsigned char* scr = P.ws() + OFF_SCR;
    const bf16_t* Rb = (const bf16_t*)(scr + S_R); const bf16_t* Kb = Rb + (size_t)MT * 1024;
    const bf16_t* Vb = j == 0 ? (const bf16_t*)(P.ws() + OFF_VF) : (const bf16_t*)(scr + S_V2);
    const bf16_t* VF = (const bf16_t*)(P.ws() + OFF_VF); const bf16_t* Ab = (const bf16_t*)(scr + S_AA); const bf16_t* Gb = Ab + (size_t)MT * 1024; const bf16_t* VG = Ab + (size_t)2 * MT * 1024;
    const bf16_t* yraw = (const bf16_t*)(scr + S_A2);
    bf16_t* yb2 = (bf16_t*)(P.ws() + OFF_SCR + S_YB2);
    const int c0 = lane * 16;
    for (int m = gw; m < MT; m += NGW) {
        const size_t o = (size_t)m * 1024 + c0;
        f32x4 y[4], vv[4]; float sum = 0.f, bon = 0.f;
#pragma unroll
        for (int q = 0; q < 4; ++q) {
            y[q] = ld_bf4(yraw + o + 4 * q);
            const f32x4 r4 = ld_bf4(Rb + o + 4 * q), k4 = ld_bf4(Kb + o + 4 * q), a4 = ld_bf4(Ab + o + 4 * q);
            f32x4 v4 = ld_bf4(Vb + o + 4 * q);
            if (j == 1) { const f32x4 vf = ld_bf4(VF + o + 4 * q), vg = ld_bf4(VG + o + 4 * q); v4 = v4 + (vf - v4) * vg; }
            vv[q] = v4;
            const f32x4 kaw = *(const f32x4*)(P.in(41) + (size_t)j * 1024 + c0 + 4 * q), rk = *(const f32x4*)(P.in(42) + (size_t)j * 1024 + c0 + 4 * q);
            const f32x4 kp = k4 * (1.f + (a4 - 1.f) * kaw), t = r4 * kp * rk;
            bon += (t[0] + t[1]) + (t[2] + t[3]);
            sum += (y[q][0] + y[q][1]) + (y[q][2] + y[q][3]);
        }
        sum = red4(sum); bon = red4(bon);
        const float mean = sum * (1.f / 64.f); float var = 0.f;
#pragma unroll
        for (int q = 0; q < 4; ++q) { const f32x4 dlt = y[q] - mean; var += (dlt[0] * dlt[0] + dlt[1] * dlt[1]) + (dlt[2] * dlt[2] + dlt[3] * dlt[3]); }
        var = red4(var) * (1.f / 64.f);
        const float rstd = rsqrtf(var + 64e-5f);
        float o16[16];
#pragma unroll
        for (int q = 0; q < 4; ++q) {
            const f32x4 gw4 = *(const f32x4*)(P.in(43) + (size_t)j * 1024 + c0 + 4 * q), gb4 = *(const f32x4*)(P.in(44) + (size_t)j * 1024 + c0 + 4 * q), g4 = ld_bf4(Gb + o + 4 * q);
            const f32x4 r = ((y[q] - mean) * rstd * gw4 + gb4 + vv[q] * bon) * g4;
            o16[4 * q] = r[0]; o16[4 * q + 1] = r[1]; o16[4 * q + 2] = r[2]; o16[4 * q + 3] = r[3];
        }
        u32x4 w0, w1;
        w0.x = cvt_pk_bf16(o16[0], o16[1]); w0.y = cvt_pk_bf16(o16[2], o16[3]); w0.z = cvt_pk_bf16(o16[4], o16[5]); w0.w = cvt_pk_bf16(o16[6], o16[7]);
        w1.x = cvt_pk_bf16(o16[8], o16[9]); w1.y = cvt_pk_bf16(o16[10], o16[11]); w1.z = cvt_pk_bf16(o16[12], o16[13]); w1.w = cvt_pk_bf16(o16[14], o16[15]);
        *(u32x4*)(yb2 + o) = w0; *(u32x4*)(yb2 + o + 8) = w1;
    }
}
__device__ __forceinline__ void phase_final(const KA P) {
    int tid_ = threadIdx.x; asm volatile("" : "+v"(tid_)); const int lane = tid_ & 63, gw = blockIdx.x * 8 + (tid_ >> 6), NGW = gridDim.x * 8;
    const bf16_t* h = (const bf16_t*)(P.ws() + OFF_SCR + S_HB2); const float* ss = (const float*)(P.ws() + OFF_SS) + (size_t)16 * MT * 16;
    for (int m = gw; m < MT; m += NGW) {
        const float s = pg8::rowscale(ss, m);
#pragma unroll
        for (int jj = 0; jj < 4; ++jj) { const int c = 4 * lane + 256 * jj;
            const u32x2 hw_ = *(const u32x2*)(h + (size_t)m * 1024 + c); f32x4 hv; hv[0] = __builtin_bit_cast(float, hw_.x << 16); hv[1] = __builtin_bit_cast(float, hw_.x & 0xffff0000u); hv[2] = __builtin_bit_cast(float, hw_.y << 16); hv[3] = __builtin_bit_cast(float, hw_.y & 0xffff0000u);
            __builtin_nontemporal_store(hv * s * *(const f32x4*)(P.in(18) + c), (f32x4*)(P.out() + (size_t)m * 1024 + c)); }
    }
}


typedef short bf16x8_t __attribute__((ext_vector_type(8)));
template <int MODE> struct SEpiResid {
    const bf16_t* hin; bf16_t* hout; float* ssn; float alpha; const bf16_t* pe; const float* ssc;
    __device__ __forceinline__ void operator()(int row, int col, f32x4 a, int tr, int tc, int wm, int wn, int fr, int fq, int tid, LAS unsigned char* lds) const {
        const size_t off = (size_t)row * 1024 + col;
        const u32x2 hw = *(const u32x2*)(hin + off);
        f32x4 hv; hv[0] = __builtin_bit_cast(float, hw.x << 16); hv[1] = __builtin_bit_cast(float, hw.x & 0xffff0000u); hv[2] = __builtin_bit_cast(float, hw.y << 16); hv[3] = __builtin_bit_cast(float, hw.y & 0xffff0000u);
        if (MODE == 0) hv = hv + a * alpha;
        else { const float s = pg8::rowscale(ssc, row); const f32x4 pv = ld_bf4(pe + off);
            hv[0] += pv[0] * sigm(s * a[0]); hv[1] += pv[1] * sigm(s * a[1]); hv[2] += pv[2] * sigm(s * a[2]); hv[3] += pv[3] * sigm(s * a[3]); }
        u32x2 w; w.x = cvt_pk_bf16(hv[0], hv[1]); w.y = cvt_pk_bf16(hv[2], hv[3]); *(u32x2*)(hout + off) = w;
        const float r0 = __builtin_bit_cast(float, w.x << 16), r1 = __builtin_bit_cast(float, w.x & 0xffff0000u), r2 = __builtin_bit_cast(float, w.y << 16), r3 = __builtin_bit_cast(float, w.y & 0xffff0000u);
        float q = (r0 * r0 + r1 * r1) + (r2 * r2 + r3 * r3);
        q += __shfl_xor(q, 16); q += __shfl_xor(q, 32);
        LAS float* part = (LAS float*)lds;
        __syncthreads();
        if (fq == 0) part[(wm * 4 + wn) * 16 + fr] = q;
        __syncthreads();
        if (tid < 32) { const int m2 = tid >> 4, f2 = tid & 15;
            const float t = (part[(m2 * 4 + 0) * 16 + f2] + part[(m2 * 4 + 1) * 16 + f2]) + (part[(m2 * 4 + 2) * 16 + f2] + part[(m2 * 4 + 3) * 16 + f2]);
            ssn[(size_t)(MP + tr * 32 + m2 * 16 + f2) * 16 + tc] = t; }
    }
};
struct SEpiPlain { bf16_t* o;
    __device__ __forceinline__ void operator()(int row, int col, f32x4 a, int, int, int, int, int, int, int, LAS unsigned char*) const { u32x2 w; w.x = cvt_pk_bf16(a[0], a[1]); w.y = cvt_pk_bf16(a[2], a[3]); *(u32x2*)(o + (size_t)row * 1024 + col) = w; }
};
template <int K, class SE> __device__ __forceinline__ void small_gemm(const bf16_t* A, const bf16_t* Bt, const SE& E, LAS unsigned char* lds) {
    static_assert(K % 256 == 0, "K/32 k-steps split over 8 waves");
    constexpr int KW = K / 256;
    int tid_ = threadIdx.x; asm volatile("" : "+v"(tid_)); const int tid = tid_, lane = tid & 63, wid = tid >> 6, fr = lane & 15, fq = lane >> 4, wm = wid & 1, wn = wid >> 1;
    LAS f32x4* red = (LAS f32x4*)(lds + 1024);
    for (int tile = blockIdx.x; tile < 256; tile += gridDim.x) {
        const int tr = tile >> 4, tc = tile & 15;
        const bf16_t* ap = A + (size_t)(MP + tr * 32 + fr) * K + wid * (KW * 32) + fq * 8;
        const bf16_t* bp = Bt + (size_t)(tc * 64 + fr) * K + wid * (KW * 32) + fq * 8;
        f32x4 acc[2][4];
#pragma unroll
        for (int a = 0; a < 2; ++a)
#pragma unroll
            for (int b = 0; b < 4; ++b) acc[a][b] = (f32x4){0.f, 0.f, 0.f, 0.f};
        constexpr int BATCH = KW < 4 ? KW : 4;
#pragma unroll
        for (int s0 = 0; s0 < KW; s0 += BATCH) {
            bf16x8_t af[BATCH][2], bf[BATCH][4];
#pragma unroll
            for (int s = 0; s < BATCH; ++s) if (s0 + s < KW) {
#pragma unroll
                for (int a = 0; a < 2; ++a) af[s][a] = *(const bf16x8_t*)(ap + (size_t)(a * 16) * K + (s0 + s) * 32);
#pragma unroll
                for (int b = 0; b < 4; ++b) bf[s][b] = *(const bf16x8_t*)(bp + (size_t)(b * 16) * K + (s0 + s) * 32); }
#pragma unroll
            for (int s = 0; s < BATCH; ++s) if (s0 + s < KW) {
#pragma unroll
                for (int a = 0; a < 2; ++a)
#pragma unroll
                    for (int b = 0; b < 4; ++b) acc[a][b] = __builtin_amdgcn_mfma_f32_16x16x32_bf16(bf[s][b], af[s][a], acc[a][b], 0, 0, 0); }
        }
        __syncthreads();
#pragma unroll
        for (int a = 0; a < 2; ++a)
#pragma unroll
            for (int b = 0; b < 4; ++b) red[(wid * 8 + a + 2 * b) * 64 + lane] = acc[a][b];
        __syncthreads();
        f32x4 tot = red[(0 * 8 + wid) * 64 + lane];
#pragma unroll
        for (int w = 1; w < 8; ++w) tot = tot + red[(w * 8 + wid) * 64 + lane];
        const int row = MP + tr * 32 + wm * 16 + fr;
        E(row, tc * 64 + wn * 16 + 4 * fq, tot, tr, tc, wm, wn, fr, fq, tid, lds);
    }
}

struct PhCtl { int ph, lo, hi; unsigned nbar; };
#ifndef MK_XCDBAR
#define MK_XCDBAR 1
#endif
#define PH_BEGIN if (C.ph >= C.lo && C.ph < C.hi) { const KA P = karg(); int G = gridDim.x, bx = blockIdx.x; asm volatile("" : "+s"(G), "+s"(bx)); (void)G; (void)bx; \
    unsigned char* ws = P.ws(); float* h = (float*)(ws + OFF_H); bf16_t* hb = (bf16_t*)(ws + OFF_HB); float* ss = (float*)(ws + OFF_SS); \
    const bf16_t* WB = (const bf16_t*)(ws + OFF_W); unsigned char* scr = ws + OFF_SCR; (void)h; (void)hb; (void)ss; (void)WB; (void)scr;
#define PH_END   if (C.ph + 1 < C.hi) { if (C.ph == 0) cg::this_grid().sync(); else if (MK_XCDBAR) { XcdBarrier xb_; xb_.bar = (unsigned*)(ws + OFF_CTL) + 64; xb_.x = xb_xcc_id(); xb_.st = (volatile LAS unsigned*)(lds + LDS_BYTES - 64); xcd_barrier(xb_); if (MK_DUP & 8) xcd_barrier(xb_); } else { ++C.nbar; grid_bar((unsigned*)(ws + OFF_CTL), C.nbar * (unsigned)G); if (MK_DUP & 8) { ++C.nbar; grid_bar((unsigned*)(ws + OFF_CTL), C.nbar * (unsigned)G); } } } } ++C.ph;

template <int I, int F> __device__ __forceinline__ void ffn_block(PhCtl& C, LAS unsigned char* lds) {
    constexpr int i = I, f = F;
    PH_BEGIN
    { pg8::Gemm g{(f == 0 && i > 0) ? (const bf16_t*)(scr + S_HB2) : hb, WB + W_FU + (size_t)(4 * f + i) * SZ_FU, MT, 5632, 1024}; pg8::StaticOrder S; S.init(MT, 5632, G, bx);
      pg8::EpiSwiGLU E{ss + (size_t)(4 * i + (f ? 2 : 0)) * MT * 16, (bf16_t*)(scr + S_ACT)};
      pg8::gemm_phase<pg8::EpiSwiGLU, pg8::StaticOrder, true, true>(lds, g, S, E);
      if (MK_DUP & 4) pg8::gemm_phase<pg8::EpiSwiGLU, pg8::StaticOrder, true, true>(lds, g, S, E); }
    if (f == 1) {
      pg8::Gemm g{(const bf16_t*)(ws + OFF_PB) + (size_t)i * MT * 256, WB + W_PI + (size_t)i * SZ_PI, MP, 1024, 256}; pg8::StaticOrder S; S.init(MP, 1024, G, bx);
      pg8::EpiPlain E{(bf16_t*)(scr + S_PE), 1024};
      pg8::gemm_phase<pg8::EpiPlain, pg8::StaticOrder, true, true>(lds, g, S, E);
      SEpiPlain SE{(bf16_t*)(scr + S_PE)};
      small_gemm<256, SEpiPlain>(g.A, g.Bt, SE, lds); }
    PH_END
    PH_BEGIN
    { pg8::Gemm g{(const bf16_t*)(scr + S_ACT), WB + W_FD + (size_t)(4 * f + i) * SZ_FD, MP, 1024, 2816}; pg8::StaticOrder S; S.init(MP, 1024, G, bx);
      pg8::EpiResid<0> E{(f == 0 && i > 0) ? (const bf16_t*)(scr + S_HB2) : (const bf16_t*)hb, hb, ss + (size_t)(4 * i + (f ? 3 : 1)) * MT * 16, 0.5f, nullptr, nullptr};
      pg8::gemm_phase<pg8::EpiResid<0>, pg8::StaticOrder, true, true>(lds, g, S, E);
      SEpiResid<0> SE{E.hin, hb, E.ssn, 0.5f, nullptr, nullptr};
      small_gemm<2816, SEpiResid<0>>(g.A, g.Bt, SE, lds); }
    PH_END
}
template <int I> __device__ __forceinline__ void mixer_block(PhCtl& C, LAS unsigned char* lds) {
    constexpr int i = I, j = I >> 1;
    if constexpr ((I & 1) == 0) {
        PH_BEGIN
        { pg8::Gemm g{hb, WB + W_MI + (size_t)j * SZ_MI, MT, 6400, 1024}; pg8::StaticOrder S; S.init(MT, 6400, G, bx);
          pg8::EpiInProj E{ss + (size_t)(4 * i + 1) * MT * 16, (bf16_t*)(scr + S_ZX), (float*)(scr + S_DTR)};
          pg8::gemm_phase<pg8::EpiInProj, pg8::StaticOrder, true, true>(lds, g, S, E);
          if (MK_DUP & 32) pg8::gemm_phase<pg8::EpiInProj, pg8::StaticOrder, true, true>(lds, g, S, E); }
        PH_END
        PH_BEGIN phase_ssd(P, j, lds); if (MK_DUP & 1) phase_ssd(P, j, lds); PH_END
        PH_BEGIN phase_mgate(P); PH_END
        PH_BEGIN
        { pg8::Gemm g{(const bf16_t*)(scr + S_YB), WB + W_MO + (size_t)j * SZ_MO, MP, 1024, 2048}; pg8::StaticOrder S; S.init(MP, 1024, G, bx);
          pg8::EpiResid<0> E{hb, hb, ss + (size_t)(4 * i + 2) * MT * 16, 1.0f, nullptr, nullptr};
          pg8::gemm_phase<pg8::EpiResid<0>, pg8::StaticOrder, true, true>(lds, g, S, E);
          SEpiResid<0> SE{hb, hb, E.ssn, 1.0f, nullptr, nullptr};
          small_gemm<2048, SEpiResid<0>>(g.A, g.Bt, SE, lds); }
        PH_END
    } else {
        PH_BEGIN phase_umix(P, i, j); if (MK_DUP & 64) phase_umix(P, i, j); PH_END
        PH_BEGIN
        { pg8::Gemm g{(const bf16_t*)(scr + S_A2), WB + W_RK + (size_t)j * SZ_RK, MT, 3584, 2048}; pg8::StaticOrder S; S.init(MT, 3584, G, bx);
          pg8::EpiRkv E{(bf16_t*)(scr + S_R), j == 0 ? (bf16_t*)(ws + OFF_VF) : (bf16_t*)(scr + S_V2), (bf16_t*)(scr + S_HID)};
          pg8::gemm_phase<pg8::EpiRkv, pg8::StaticOrder, true, true>(lds, g, S, E);
          if (MK_DUP & 32) pg8::gemm_phase<pg8::EpiRkv, pg8::StaticOrder, true, true>(lds, g, S, E); }
        PH_END
        PH_BEGIN
        { constexpr int N2 = j == 0 ? 3072 : 4096;
          pg8::Gemm g{(const bf16_t*)(scr + S_HID), WB + W_L2 + (size_t)j * SZ_L2, MT, N2, 384}; pg8::StaticOrder S; S.init(MT, N2, G, bx);
          pg8::EpiLora2 E{(float*)(scr + S_DD), (bf16_t*)(scr + S_AA), P.in(32) + (size_t)j * 1024, P.in(35) + (size_t)j * 1024, P.in(45)};
          pg8::gemm_phase<pg8::EpiLora2, pg8::StaticOrder, true, true>(lds, g, S, E); }
        PH_END
        PH_BEGIN phase_wkv(P, j, lds); if (MK_DUP & 2) phase_wkv(P, j, lds); PH_END
        PH_BEGIN phase_rpost(P, j); if (MK_DUP & 64) phase_rpost(P, j); PH_END
        PH_BEGIN
        { pg8::Gemm g{(const bf16_t*)(scr + S_YB2), WB + W_RO + (size_t)j * SZ_RO, MP, 1024, 1024}; pg8::StaticOrder S; S.init(MP, 1024, G, bx);
          pg8::EpiResid<0> E{hb, hb, ss + (size_t)(4 * i + 2) * MT * 16, 1.0f, nullptr, nullptr};
          pg8::gemm_phase<pg8::EpiResid<0>, pg8::StaticOrder, true, true>(lds, g, S, E);
          SEpiResid<0> SE{hb, hb, E.ssn, 1.0f, nullptr, nullptr};
          small_gemm<1024, SEpiResid<0>>(g.A, g.Bt, SE, lds); }
        PH_END
    }
}
template <int I> __device__ __forceinline__ void layer_block(PhCtl& C, LAS unsigned char* lds) {
    constexpr int i = I;
    ffn_block<I, 0>(C, lds);
    mixer_block<I>(C, lds);
    ffn_block<I, 1>(C, lds);
    PH_BEGIN
    { pg8::Gemm g{hb, WB + W_PG + (size_t)i * SZ_PG, MP, 1024, 1024}; pg8::StaticOrder S; S.init(MP, 1024, G, bx);
      pg8::EpiResid<1> E{hb, (bf16_t*)(scr + S_HB2), ss + (size_t)(4 * i + 4) * MT * 16, 0.f, (const bf16_t*)(scr + S_PE), ss + (size_t)(4 * i + 3) * MT * 16};
      pg8::gemm_phase<pg8::EpiResid<1>, pg8::StaticOrder, true, true>(lds, g, S, E);
      SEpiResid<1> SE{hb, E.hout, E.ssn, 0.f, E.pe, E.ssc};
      small_gemm<1024, SEpiResid<1>>(g.A, g.Bt, SE, lds); }
    PH_END
}
__global__ void __launch_bounds__(512, 2) mk_fwd(Params Pdummy) {
    extern __shared__ __attribute__((aligned(16))) unsigned char lds_raw[];
    LAS unsigned char* lds = (LAS unsigned char*)lds_raw;
    PhCtl C; C.ph = 0; C.nbar = 0;
    if (MK_XCDBAR && !MK_PER_PHASE) { if (threadIdx.x < 16) ((volatile LAS unsigned*)(lds + LDS_BYTES - 64))[threadIdx.x] = 0u; __syncthreads();
        const KA k1 = karg(); (void)xcd_barrier_post((unsigned*)(k1.ws() + OFF_CTL) + 64, (volatile LAS unsigned*)(lds + LDS_BYTES - 64)); }
    { const KA k0 = karg(); C.lo = *(const int __attribute__((address_space(4)))*)(k0.p + 400); C.hi = *(const int __attribute__((address_space(4)))*)(k0.p + 404); }
    PH_BEGIN phase_prologue(P, lds); if (MK_DUP & 16) phase_prologue(P, lds); PH_END
    layer_block<0>(C, lds);
    layer_block<1>(C, lds);
    layer_block<2>(C, lds);
    layer_block<3>(C, lds);
    PH_BEGIN phase_final(P); if (MK_DUP & 64) phase_final(P); PH_END
}
#undef PH_BEGIN
#undef PH_END
constexpr int N_PHASES = 1 + 2 * (4 + 4 + 1) + 2 * (4 + 6 + 1) + 1;

extern "C" void kernel_launch(void* const* d_in, const int* in_sizes, int n_in, void* d_out, int out_size, void* d_ws, size_t ws_size, hipStream_t stream) {
    static int grid = 0;
    if (grid == 0) {
        if (n_in != 48 || (size_t)out_size != O_TOTAL || ws_size < WS_NEED) { fprintf(stderr, "kernel_launch: unexpected shapes n_in %d out %d ws %zu (need %zu)\n", n_in, out_size, ws_size, (size_t)WS_NEED); grid = -1; return; }
        int dev = 0, cus = 0, per_cu = 0;
        hipGetDevice(&dev); hipDeviceGetAttribute(&cus, hipDeviceAttributeMultiprocessorCount, dev);
        if (hipFuncSetAttribute((const void*)mk_fwd, hipFuncAttributeMaxDynamicSharedMemorySize, LDS_BYTES) != hipSuccess) { fprintf(stderr, "kernel_launch: hipFuncSetAttribute failed\n"); grid = -1; return; }
        if (hipOccupancyMaxActiveBlocksPerMultiprocessor(&per_cu, (const void*)mk_fwd, 512, LDS_BYTES) != hipSuccess || per_cu < 1) { fprintf(stderr, "kernel_launch: occupancy query says %d\n", per_cu); per_cu = 1; }
        (void)hipGetLastError();
        grid = cus * 1;
    }
    if (grid < 0) return;
    if (hipMemsetAsync((char*)d_ws + OFF_CTL, 0, 16384, stream) != hipSuccess) { fprintf(stderr, "kernel_launch: memset failed\n"); return; }
    Params p{};
    for (int i = 0; i < 48; ++i) p.in[i] = (const float*)d_in[i];
    p.out = (float*)d_out; p.ws = (unsigned char*)d_ws;
#if MK_PER_PHASE
    for (int k = 0; k < N_PHASES; ++k) { p.ph_lo = k; p.ph_hi = k + 1; hipLaunchKernelGGL(mk_fwd, dim3(grid), dim3(512), LDS_BYTES, stream, p); }
#else
    p.ph_lo = 0; p.ph_hi = N_PHASES;
    void* args[] = {&p};
    hipError_t e = hipLaunchCooperativeKernel((const void*)mk_fwd, dim3(grid), dim3(512), args, LDS_BYTES, stream);
    if (e != hipSuccess) fprintf(stderr, "cooperative launch failed: %s (grid %d)\n", hipGetErrorString(e), grid);
#endif
}
```
